# Optimizing an MI355X kernel written in HIP

```python
import math
import jax, jax.numpy as jnp
from jax import lax
import numpy as np

D_MODEL = 2048
BATCH = 1
SEQ = 8192
DEPTH = 2

D_MIX = D_MODEL
SSD_HEADS = 16
SSD_HEAD_DIM = 64
SSD_WIDTH = SSD_HEADS * SSD_HEAD_DIM
SSD_GROUPS = 2
SSD_STATE = 128
SSD_CONV = 4
SSD_CHUNK = 256
SSD_XBC = SSD_WIDTH + 2 * SSD_GROUPS * SSD_STATE
MOBA_HEADS = 8
MOBA_HEAD_DIM = 64
MOBA_WIDTH = MOBA_HEADS * MOBA_HEAD_DIM
MOBA_BLOCK = 256
MOBA_TOPK = 3
DIFF_HEADS = 4
DIFF_QK_DIM = 64
DIFF_V_DIM = 2 * DIFF_QK_DIM
DIFF_QK_WIDTH = DIFF_HEADS * 2 * DIFF_QK_DIM
DIFF_WIDTH = DIFF_HEADS * DIFF_V_DIM
ATTN_HEADS = MOBA_HEADS + DIFF_HEADS
Q_BLOCK = 128
REL_BUCKETS = 32
REL_MAX_DIST = 128
D_FF_DENSE = 5632
N_EXPERTS = 8
TOP_K = 2
D_FF_EXPERT = 7168
N_DENSE = (DEPTH + 1) // 2
N_MOE = DEPTH // 2
EPS = 1e-6
IN_SPLITS = (SSD_WIDTH, SSD_XBC, SSD_HEADS, MOBA_WIDTH, MOBA_WIDTH, MOBA_WIDTH, DIFF_QK_WIDTH, DIFF_QK_WIDTH, DIFF_WIDTH)
D_IN_PROJ = sum(IN_SPLITS)

kernel_name = 'hybrid_ssd_moba_diffattn_adaln_moe'


def rmsnorm(x, g):
    xf = x.astype(jnp.float32)
    y = xf * lax.rsqrt(jnp.mean(xf * xf, axis=-1, keepdims=True) + EPS)
    return (y * g.astype(jnp.float32)).astype(x.dtype)


def pad_seq(u, multiple, mode='constant'):
    extra = (-u.shape[1]) % multiple
    if extra == 0:
        return u
    widths = [(0, 0)] * u.ndim
    widths[1] = (0, extra)
    return jnp.pad(u, widths, mode=mode)


def rel_bucket(dist):
    n = jnp.maximum(dist, 0)
    max_exact = REL_BUCKETS // 2
    nf = jnp.maximum(n, 1).astype(jnp.float32)
    large = max_exact + (jnp.log(nf / max_exact) / math.log(REL_MAX_DIST / max_exact)
                         * (REL_BUCKETS - max_exact)).astype(jnp.int32)
    large = jnp.minimum(large, REL_BUCKETS - 1)
    return jnp.where(n < max_exact, n, large)


def ssd_mixer(z, xbc, dt, conv_w, conv_b, dt_bias, a_log, d_skip, norm_g):
    f32 = jnp.float32
    L = z.shape[1]
    z, xbc, dt = (pad_seq(u, SSD_CHUNK) for u in (z, xbc, dt))
    B_, Lp, _ = z.shape
    nc = Lp // SSD_CHUNK
    R = SSD_HEADS // SSD_GROUPS
    xbc = lax.conv_general_dilated(xbc, conv_w[:, None, :].astype(xbc.dtype), (1,), [(SSD_CONV - 1, 0)],
                                   dimension_numbers=('NWC', 'WIO', 'NWC'), feature_group_count=SSD_XBC)
    xbc = jax.nn.silu(xbc + conv_b)
    xs, bm, cm = jnp.split(xbc.astype(f32), [SSD_WIDTH, SSD_WIDTH + SSD_GROUPS * SSD_STATE], axis=-1)
    xs = xs.reshape(B_, nc, SSD_CHUNK, SSD_GROUPS, R, SSD_HEAD_DIM)
    bm = bm.reshape(B_, nc, SSD_CHUNK, SSD_GROUPS, SSD_STATE)
    cm = cm.reshape(B_, nc, SSD_CHUNK, SSD_GROUPS, SSD_STATE)
    dt = jax.nn.softplus(dt.astype(f32) + dt_bias.astype(f32)).reshape(B_, nc, SSD_CHUNK, SSD_GROUPS, R)
    a = -jnp.exp(a_log.astype(f32)).reshape(SSD_GROUPS, R)
    a_cs = jnp.cumsum(jnp.moveaxis(dt * a, 2, -1), axis=-1)
    xdt = xs * dt[..., None]
    tril = jnp.tril(jnp.ones((SSD_CHUNK, SSD_CHUNK), dtype=bool))
    decay = jnp.exp(jnp.where(tril, a_cs[..., :, None] - a_cs[..., None, :], -jnp.inf))
    cb = jnp.einsum('bclgn,bcsgn->bcgls', cm, bm)
    y_diag = jnp.einsum('bcgrls,bcsgrp->bclgrp', cb[:, :, :, None] * decay, xdt)
    to_end = jnp.exp(a_cs[..., -1:] - a_cs)
    chunk_states = jnp.einsum('bclgn,bcgrl,bclgrp->bcgrpn', bm, to_end, xdt)
    chunk_decay = jnp.exp(a_cs[..., -1])

    def carry_state(h, inp):
        s_c, d_c = inp
        return h * d_c[..., None, None] + s_c, h

    h0 = jnp.zeros((B_, SSD_GROUPS, R, SSD_HEAD_DIM, SSD_STATE), f32)
    _, h_prev = lax.scan(carry_state, h0, (jnp.moveaxis(chunk_states, 1, 0), jnp.moveaxis(chunk_decay, 1, 0)))
    h_prev = jnp.moveaxis(h_prev, 0, 1)
    y_off = jnp.einsum('bclgn,bcgrpn,bcgrl->bclgrp', cm, h_prev, jnp.exp(a_cs))
    y = y_diag + y_off + xs * d_skip.astype(f32).reshape(SSD_GROUPS, R)[:, :, None]
    y = y.reshape(B_, Lp, SSD_WIDTH) * jax.nn.silu(z.astype(f32))
    y = y.reshape(B_, Lp, SSD_GROUPS, SSD_WIDTH // SSD_GROUPS)
    y = y * lax.rsqrt(jnp.mean(y * y, axis=-1, keepdims=True) + EPS)
    y = y.reshape(B_, Lp, SSD_WIDTH) * norm_g.astype(f32)
    return y[:, :L].astype(z.dtype)


def moba_mixer(q, k, v, positions, bias_tbl, norm_g):
    f32 = jnp.float32
    L = q.shape[1]
    q, k, v = (pad_seq(u, MOBA_BLOCK) for u in (q, k, v))
    pos = pad_seq(positions, MOBA_BLOCK, mode='edge')
    B_, Lp = q.shape[:2]
    H, S, Dh = MOBA_HEADS, MOBA_BLOCK, MOBA_HEAD_DIM
    nb = Lp // S
    k_sel = min(MOBA_TOPK, nb)
    scale = Dh ** -0.5
    qh = jnp.transpose(q, (0, 2, 1, 3))
    kb = jnp.transpose(k, (0, 2, 1, 3)).reshape(B_, H, nb, S, Dh)
    vb = jnp.transpose(v, (0, 2, 1, 3)).reshape(B_, H, nb, S, Dh)
    k_mean = jnp.mean(kb.astype(f32), axis=3)
    pos_b = pos.reshape(B_, nb, S)
    bi = jnp.arange(B_)[:, None, None, None]
    hi = jnp.arange(H)[None, :, None, None]
    hb = hi[..., None]
    blk = jnp.arange(nb)
    offs_q = jnp.arange(Q_BLOCK)
    offs_k = jnp.arange(S)

    def query_block(qi):
        start = qi * Q_BLOCK
        own = start // S
        qb = lax.dynamic_slice_in_dim(qh, start, Q_BLOCK, axis=2)
        qpos = lax.dynamic_slice_in_dim(pos, start, Q_BLOCK, axis=1)
        gate = jnp.einsum('bhqd,bhjd->bhqj', qb.astype(f32), k_mean)
        gate = jnp.where(blk < own, gate, -jnp.inf)
        _, idx = lax.top_k(gate, k_sel)
        valid = idx < own
        k_g = kb[bi, hi, idx]
        v_g = vb[bi, hi, idx]
        kpos = pos_b[bi, idx]
        s_past = jnp.einsum('bhqd,bhqksd->bhqks', qb, k_g).astype(f32) * scale
        s_past = s_past + bias_tbl[hb, rel_bucket(qpos[:, None, :, None, None] - kpos)].astype(f32)
        s_past = jnp.where(valid[..., None], s_past, -jnp.inf)
        k_own = lax.dynamic_index_in_dim(kb, own, axis=2, keepdims=False)
        v_own = lax.dynamic_index_in_dim(vb, own, axis=2, keepdims=False)
        kpos_own = lax.dynamic_index_in_dim(pos_b, own, axis=1, keepdims=False)
        s_own = jnp.einsum('bhqd,bhsd->bhqs', qb, k_own).astype(f32) * scale
        bias_own = bias_tbl[:, rel_bucket(qpos[:, :, None] - kpos_own[:, None, :])]
        s_own = s_own + jnp.transpose(bias_own, (1, 0, 2, 3)).astype(f32)
        causal = (own * S + offs_k)[None, :] <= (start + offs_q)[:, None]
        s_own = jnp.where(causal, s_own, -jnp.inf)
        logits = jnp.concatenate([s_past.reshape(B_, H, Q_BLOCK, k_sel * S), s_own], axis=-1)
        p = jax.nn.softmax(logits, axis=-1).astype(v.dtype)
        p_past = p[..., : k_sel * S].reshape(B_, H, Q_BLOCK, k_sel, S)
        p_own = p[..., k_sel * S:]
        return (jnp.einsum('bhqks,bhqksd->bhqd', p_past, v_g)
                + jnp.einsum('bhqs,bhsd->bhqd', p_own, v_own))

    out = lax.map(query_block, jnp.arange(Lp // Q_BLOCK))
    out = jnp.transpose(out, (1, 0, 3, 2, 4)).reshape(B_, Lp, H, Dh)[:, :L]
    return rmsnorm(out, norm_g.reshape(H, Dh)).reshape(B_, L, MOBA_WIDTH)


def diff_mixer(q, k, v, positions, bias_tbl, lam_params, subln_g, lambda_init):
    f32 = jnp.float32
    B_, L = q.shape[:2]
    scale = DIFF_QK_DIM ** -0.5
    lp = lam_params.astype(f32)
    lam = jnp.exp(jnp.sum(lp[0] * lp[1])) - jnp.exp(jnp.sum(lp[2] * lp[3])) + lambda_init
    qh = jnp.transpose(q, (0, 2, 3, 1, 4))
    kh = jnp.transpose(k, (0, 2, 3, 1, 4))
    vh = jnp.transpose(v, (0, 2, 1, 3))
    offs_q = jnp.arange(Q_BLOCK)
    key_idx = jnp.arange(L)

    def query_block(qi):
        start = qi * Q_BLOCK
        qb = lax.dynamic_slice_in_dim(qh, start, Q_BLOCK, axis=3)
        qpos = lax.dynamic_slice_in_dim(positions, start, Q_BLOCK, axis=1)
        s = jnp.einsum('bhmqd,bhmkd->bhmqk', qb, kh).astype(f32) * scale
        bias = bias_tbl[:, rel_bucket(qpos[:, :, None] - positions[:, None, :])]
        s = s + jnp.transpose(bias, (1, 0, 2, 3))[:, :, None].astype(f32)
        causal = key_idx[None, :] <= (start + offs_q)[:, None]
        p = jax.nn.softmax(jnp.where(causal, s, -jnp.inf), axis=-1)
        attn = p[:, :, 0] - lam * p[:, :, 1]
        return jnp.einsum('bhqk,bhkd->bhqd', attn.astype(v.dtype), vh)

    out = lax.map(query_block, jnp.arange(L // Q_BLOCK))
    out = jnp.transpose(out, (1, 0, 3, 2, 4)).reshape(B_, L, DIFF_HEADS, DIFF_V_DIM)
    out = rmsnorm(out, subln_g) * (1.0 - lambda_init)
    return out.reshape(B_, L, DIFF_WIDTH)


def token_mixers(h, positions, rel_bias, w_in, conv_w, conv_b, dt_bias, a_log, d_skip, ssd_norm_g,
                 moba_norm_g, diff_lambda, diff_subln_g, w_out, lambda_init):
    B_, L, _ = h.shape
    proj = jnp.einsum('bld,de->ble', h, w_in)
    points = np.cumsum(IN_SPLITS)[:-1].tolist()
    z, xbc, dt, mq, mk, mv, dq, dk, dv = jnp.split(proj, points, axis=-1)
    y_ssd = ssd_mixer(z, xbc, dt, conv_w, conv_b, dt_bias, a_log, d_skip, ssd_norm_g)
    mshape = (B_, L, MOBA_HEADS, MOBA_HEAD_DIM)
    y_moba = moba_mixer(mq.reshape(mshape), mk.reshape(mshape), mv.reshape(mshape), positions,
                        rel_bias[:, :MOBA_HEADS].T, moba_norm_g)
    dshape = (B_, L, DIFF_HEADS, 2, DIFF_QK_DIM)
    y_diff = diff_mixer(dq.reshape(dshape), dk.reshape(dshape), dv.reshape(B_, L, DIFF_HEADS, DIFF_V_DIM),
                        positions, rel_bias[:, MOBA_HEADS:].T, diff_lambda, diff_subln_g, lambda_init)
    y = jnp.concatenate([y_ssd, y_moba, y_diff], axis=-1)
    return jnp.einsum('ble,ed->bld', y, w_out)


def swiglu(h, w1, w3, w2):
    a = jnp.einsum('bld,df->blf', h, w1)
    b = jnp.einsum('bld,df->blf', h, w3)
    return jnp.einsum('blf,fd->bld', jax.nn.silu(a) * b, w2)


def moe_ffn(h, router_w, w1, w3, w2):
    logits = jnp.einsum('bld,de->ble', h, router_w).astype(jnp.float32)
    top_v, top_i = lax.top_k(logits, TOP_K)
    top_w = jax.nn.softmax(top_v, axis=-1)
    comb = jnp.sum(jax.nn.one_hot(top_i, N_EXPERTS, dtype=jnp.float32) * top_w[..., None], axis=-2)
    out = jnp.zeros_like(h)
    for e in range(N_EXPERTS):
        out = out + comb[..., e:e + 1].astype(h.dtype) * swiglu(h, w1[e], w3[e], w2[e])
    return out


def setup_inputs(seed: int = 0) -> dict:
    key = jax.random.key(seed)
    ks = jax.random.split(key, 32)
    f32 = jnp.float32

    def normal(k, shape, scale):
        return jax.random.normal(k, shape, f32) * scale

    def gain(k, shape):
        return 1.0 + 0.02 * jax.random.normal(k, shape, f32)

    x = normal(ks[0], (BATCH, SEQ, D_MODEL), 1.0)
    c = normal(ks[1], (BATCH, D_MODEL), 1.0)
    positions = jnp.broadcast_to(jnp.arange(SEQ, dtype=jnp.int32), (BATCH, SEQ))
    rel_bias = normal(ks[2], (REL_BUCKETS, ATTN_HEADS), 0.5)
    w_ada = normal(ks[3], (DEPTH, D_MODEL, 6 * D_MODEL), D_MODEL ** -0.5)
    b_ada = normal(ks[4], (DEPTH, 6 * D_MODEL), 0.02)
    norm_mix_g = gain(ks[5], (DEPTH, D_MODEL))
    w_in = normal(ks[6], (DEPTH, D_MODEL, D_IN_PROJ), D_MODEL ** -0.5)
    conv_w = normal(ks[7], (DEPTH, SSD_CONV, SSD_XBC), SSD_CONV ** -0.5)
    conv_b = normal(ks[8], (DEPTH, SSD_XBC), 0.02)
    u = jax.random.uniform(ks[9], (DEPTH, SSD_HEADS), f32)
    dt0 = jnp.exp(u * (math.log(0.1) - math.log(0.001)) + math.log(0.001))
    dt_bias = dt0 + jnp.log(-jnp.expm1(-dt0))
    a_log = jnp.log(jax.random.uniform(ks[10], (DEPTH, SSD_HEADS), f32, 1.0, 16.0))
    d_skip = gain(ks[11], (DEPTH, SSD_HEADS))
    ssd_norm_g = gain(ks[12], (DEPTH, SSD_WIDTH))
    moba_norm_g = gain(ks[13], (DEPTH, MOBA_WIDTH))
    diff_lambda = normal(ks[14], (DEPTH, 4, DIFF_QK_DIM), 0.1)
    diff_subln_g = gain(ks[15], (DEPTH, DIFF_V_DIM))
    w_out = normal(ks[16], (DEPTH, D_MIX, D_MODEL), D_MIX ** -0.5)
    norm_ffn_g = gain(ks[17], (DEPTH, D_MODEL))
    dense_w1 = normal(ks[18], (N_DENSE, D_MODEL, D_FF_DENSE), D_MODEL ** -0.5)
    dense_w3 = normal(ks[19], (N_DENSE, D_MODEL, D_FF_DENSE), D_MODEL ** -0.5)
    dense_w2 = normal(ks[20], (N_DENSE, D_FF_DENSE, D_MODEL), D_FF_DENSE ** -0.5)
    router_w = normal(ks[21], (N_MOE, D_MODEL, N_EXPERTS), D_MODEL ** -0.5)
    expert_w1 = normal(ks[22], (N_MOE, N_EXPERTS, D_MODEL, D_FF_EXPERT), D_MODEL ** -0.5)
    expert_w3 = normal(ks[23], (N_MOE, N_EXPERTS, D_MODEL, D_FF_EXPERT), D_MODEL ** -0.5)
    expert_w2 = normal(ks[24], (N_MOE, N_EXPERTS, D_FF_EXPERT, D_MODEL), D_FF_EXPERT ** -0.5)
    final_g = gain(ks[25], (D_MODEL,))
    return {'x': x, 'c': c, 'positions': positions, 'rel_bias': rel_bias, 'w_ada': w_ada, 'b_ada': b_ada,
            'norm_mix_g': norm_mix_g, 'w_in': w_in, 'conv_w': conv_w, 'conv_b': conv_b, 'dt_bias': dt_bias,
            'a_log': a_log, 'd_skip': d_skip, 'ssd_norm_g': ssd_norm_g, 'moba_norm_g': moba_norm_g,
            'diff_lambda': diff_lambda, 'diff_subln_g': diff_subln_g, 'w_out': w_out, 'norm_ffn_g': norm_ffn_g,
            'dense_w1': dense_w1, 'dense_w3': dense_w3, 'dense_w2': dense_w2, 'router_w': router_w,
            'expert_w1': expert_w1, 'expert_w3': expert_w3, 'expert_w2': expert_w2, 'final_g': final_g}


def reference(x, c, positions, rel_bias, w_ada, b_ada, norm_mix_g, w_in, conv_w, conv_b, dt_bias, a_log,
              d_skip, ssd_norm_g, moba_norm_g, diff_lambda, diff_subln_g, w_out, norm_ffn_g, dense_w1,
              dense_w3, dense_w2, router_w, expert_w1, expert_w3, expert_w2, final_g):
    c_act = jax.nn.silu(c)
    for layer in range(DEPTH):
        lambda_init = 0.8 - 0.6 * math.exp(-0.3 * layer)
        mod = jnp.einsum('bd,de->be', c_act, w_ada[layer]) + b_ada[layer]
        shift1, scale1, gate1, shift2, scale2, gate2 = jnp.split(mod[:, None, :], 6, axis=-1)
        h = rmsnorm(x, norm_mix_g[layer]) * (1.0 + scale1) + shift1
        y = token_mixers(h, positions, rel_bias, w_in[layer], conv_w[layer], conv_b[layer], dt_bias[layer],
                         a_log[layer], d_skip[layer], ssd_norm_g[layer], moba_norm_g[layer],
                         diff_lambda[layer], diff_subln_g[layer], w_out[layer], lambda_init)
        x = x + gate1 * y
        h = rmsnorm(x, norm_ffn_g[layer]) * (1.0 + scale2) + shift2
        i = layer // 2
        if layer % 2 == 0:
            y = swiglu(h, dense_w1[i], dense_w3[i], dense_w2[i])
        else:
            y = moe_ffn(h, router_w[i], expert_w1[i], expert_w3[i], expert_w2[i])
        x = x + gate2 * y
    return rmsnorm(x, final_g)
```

```cpp
#include <hip/hip_runtime.h>
#include <cstdio>
#include <cstdint>
#ifndef OUTPROJ_FP8
#define OUTPROJ_FP8 1
#endif
#ifndef MK_MULTI
#define MK_MULTI 0
#endif
namespace pg8 {
#define PG8_LAS __attribute__((address_space(3)))
typedef unsigned short bf16_t;
typedef short bf16x8 __attribute__((ext_vector_type(8)));
typedef float f32x4 __attribute__((ext_vector_type(4)));
typedef unsigned u32x4 __attribute__((ext_vector_type(4)));
constexpr int BM = 256, BK = 64, HALF = 128, HTB = HALF * BK * 2  , STAGE_BYTES = 8 * HTB, NXCD = 8, WGM = 8;

__host__ __device__ __forceinline__ int lds_byte(int r, int c) { const int st = (r >> 4) * 2 + (c >> 5), rr = r & 15, cc = c & 31, ob = rr * 64 + cc * 2; return st * 1024 + (ob ^ (((ob >> 9) & 1) << 5)); }
__host__ __device__ __forceinline__ void stage_rc(int b, int& R, int& C) { const int st = b / 1024, sb = b % 1024, swz = sb ^ (((sb >> 9) & 1) << 5); R = (st >> 1) * 16 + swz / 64; C = (st & 1) * 32 + (swz % 64) / 2; }
__host__ __device__ __forceinline__ int perm32(int rho) { const int n = rho >> 4, i = rho & 15; return 8 * (i >> 2) + 4 * n + (i & 3); }

struct Unit { int pm, pn, ko, po; };
struct Gemm { const bf16_t* A; const bf16_t* Bt; int M, N, K, KS; };

struct StaticOrder {
    int nM, nN, nwg, G, c;
    __host__ __device__ void init(int M, int N, int G_, int c_) { nM = M / BM; nN = N / BM; nwg = nM * nN; G = G_; c = c_; }
    __host__ __device__ bool next(int i, Unit& u) const {
        const long L = (long)i * G + c; if (L >= nwg) return false;
        int wgid = (int)L; { const int q = nwg / NXCD, r = nwg % NXCD, xcd = wgid % NXCD, off = wgid / NXCD; wgid = (xcd < r ? xcd * (q + 1) : r * (q + 1) + (xcd - r) * q) + off; }
        const int nig = WGM * nN, gid = wgid / nig, fm = gid * WGM, gsz = (nM - fm) < WGM ? (nM - fm) : WGM;
        u.pm = fm + ((wgid % nig) % gsz); u.pn = (wgid % nig) / gsz; u.ko = 0; u.po = u.pm; return true;
    }
    __device__ __forceinline__ void a_ready(const Unit&) const {}
    __device__ __forceinline__ void done(const Unit&) const {}
};
__device__ __forceinline__ unsigned cvt_pk_bf16(float lo, float hi) { unsigned r; asm volatile("v_cvt_pk_bf16_f32 %0, %1, %2" : "=v"(r) : "v"(lo), "v"(hi)); return r; }
typedef float f32x2 __attribute__((ext_vector_type(2)));
typedef int pg8_v8i __attribute__((ext_vector_type(8))); typedef int pg8_v4i __attribute__((ext_vector_type(4)));
template <class Epi, class Sched, bool ALIGN_EPI = false, bool SP2 = false, bool FP8 = false>
__device__ __forceinline__ void gemm_phase(PG8_LAS unsigned char* lds, const Gemm g, const Sched& S, const Epi& E) {
    const int tid = threadIdx.x, wid = __builtin_amdgcn_readfirstlane(tid >> 6), lane = tid & 63, wr = wid >> 2, wc = wid & 3, fr = lane & 15, fq = lane >> 4;
    const int K = g.K, nt = (g.KS ? g.KS : K) / BK;
    unsigned voffA[1], voffB[1];
    { int R, C; stage_rc(tid * 16, R, C); const int Rb = Epi::PERM ? ((R & ~31) + perm32(R & 31)) : R;
        voffA[0] = (unsigned)(R * K + C) * 2u; voffB[0] = (unsigned)(Rb * K + C) * 2u; }
    const size_t qstep = (size_t)64 * K * 2;
    const size_t kstep = (size_t)(BK * 2);
    const size_t hstep = (size_t)HALF * K * 2;
    const size_t tstep = 2 * hstep;
    const unsigned ldsw = (unsigned)wid * 1024u;
    const int aoff = lds_byte(wr * 64 + fr, fq * 8), boff = lds_byte(wc * 32 + fr, fq * 8);
#define PG8_SA(b, h) (((b) * 2 + (h)) * HTB)
#define PG8_SB(b, h) ((4 + (b) * 2 + (h)) * HTB)
#define PG8_STAGE(bufoff, gbase, voff) do { _Pragma("unroll") for (int _i = 0; _i < 2; ++_i) \
        __builtin_amdgcn_global_load_lds((const unsigned*)((const char*)(gbase) + _i * qstep + (voff)[0]), (PG8_LAS unsigned*)(lds + (bufoff) + ldsw + _i * 8192), 16, 0, 0); } while (0)
#define PG8_LDA(dst, b, h) do { if constexpr (FP8) { _Pragma("unroll") for (int m = 0; m < 4; ++m) { const pg8_v4i lo_ = *(const PG8_LAS pg8_v4i*)(lds + PG8_SA(b, h) + aoff + m * 2048), hi_ = *(const PG8_LAS pg8_v4i*)(lds + PG8_SA(b, h) + aoff + m * 2048 + 1024); \
        dst##8[m] = __builtin_shufflevector(lo_, hi_, 0, 1, 2, 3, 4, 5, 6, 7); } } else { _Pragma("unroll") for (int m = 0; m < 4; ++m) _Pragma("unroll") for (int k = 0; k < 2; ++k) dst[m][k] = *(const PG8_LAS bf16x8*)(lds + PG8_SA(b, h) + aoff + m * 2048 + k * 1024); } } while (0)
#define PG8_LDB(dst, b, h) do { if constexpr (FP8) { _Pragma("unroll") for (int n = 0; n < 2; ++n) { const pg8_v4i lo_ = *(const PG8_LAS pg8_v4i*)(lds + PG8_SB(b, h) + boff + n * 2048), hi_ = *(const PG8_LAS pg8_v4i*)(lds + PG8_SB(b, h) + boff + n * 2048 + 1024); \
        dst##8[n] = __builtin_shufflevector(lo_, hi_, 0, 1, 2, 3, 4, 5, 6, 7); } } else { _Pragma("unroll") for (int n = 0; n < 2; ++n) _Pragma("unroll") for (int k = 0; k < 2; ++k) dst[n][k] = *(const PG8_LAS bf16x8*)(lds + PG8_SB(b, h) + boff + n * 2048 + k * 1024); } } while (0)
#define PG8_MMA(ai, bj, At, Bt) do { __builtin_amdgcn_s_setprio(1); _Pragma("unroll") for (int m = 0; m < 4; ++m) _Pragma("unroll") for (int n = 0; n < 2; ++n) { \
        if constexpr (FP8) { asm volatile("v_mfma_f32_16x16x128_f8f6f4 %0, %1, %2, %0" : "+v"(acc[ai][bj][m][n]) : "v"(Bt##8[n]), "v"(At##8[m])); }     \
        else { _Pragma("unroll") for (int k = 0; k < 2; ++k) acc[ai][bj][m][n] = __builtin_amdgcn_mfma_f32_16x16x32_bf16(Bt[n][k], At[m][k], acc[ai][bj][m][n], 0, 0, 0); } } \
        __builtin_amdgcn_s_setprio(0); } while (0)
#define PG8_WAIT_V(n) asm volatile("s_waitcnt vmcnt(" #n ")" ::: "memory")
#define PG8_WAIT_L(n) asm volatile("s_waitcnt lgkmcnt(" #n ")" ::: "memory")
#define PG8_BAR __builtin_amdgcn_s_barrier()
#define PG8_SCHED __builtin_amdgcn_sched_barrier(0)
    Unit cur, nxt; int ui = 0;
    if (!S.next(0, cur)) return;
    f32x4 acc[2][2][4][2];
#pragma unroll
    for (int a = 0; a < 2; ++a)
#pragma unroll
        for (int b = 0; b < 2; ++b)
#pragma unroll
            for (int m = 0; m < 4; ++m)
#pragma unroll
                for (int n = 0; n < 2; ++n) acc[a][b][m][n] = (f32x4){0.f, 0.f, 0.f, 0.f};
    bf16x8 At[4][2], B0[2][2], B1[2][2]; pg8_v8i At8[4], B08[2], B18[2];
    const char* cA = (const char*)g.A + (size_t)cur.pm * tstep + cur.ko; const char* cB = (const char*)g.Bt + (size_t)cur.pn * tstep + cur.ko;
    S.a_ready(cur);
    if constexpr (SP2) {
        PG8_STAGE(PG8_SB(0, 0), cB, voffB); PG8_STAGE(PG8_SB(0, 1), cB + hstep, voffB); PG8_STAGE(PG8_SA(0, 0), cA, voffA); PG8_STAGE(PG8_SA(0, 1), cA + hstep, voffA);
        if (wr == 1) PG8_BAR;
        PG8_WAIT_V(2); PG8_BAR;
        PG8_STAGE(PG8_SB(1, 0), cB + kstep, voffB); PG8_STAGE(PG8_SA(1, 0), cA + kstep, voffA); PG8_STAGE(PG8_SB(1, 1), cB + hstep + kstep, voffB);
        PG8_WAIT_V(6); PG8_BAR;
    } else {
        PG8_STAGE(PG8_SB(0, 0), cB, voffB); PG8_STAGE(PG8_SA(0, 0), cA, voffA); PG8_STAGE(PG8_SB(0, 1), cB + hstep, voffB); PG8_STAGE(PG8_SA(0, 1), cA + hstep, voffA);
        if (wr == 1) PG8_BAR;
        PG8_WAIT_V(4); PG8_BAR;
        PG8_STAGE(PG8_SB(1, 0), cB + kstep, voffB); PG8_STAGE(PG8_SA(1, 0), cA + kstep, voffA); PG8_STAGE(PG8_SB(1, 1), cB + hstep + kstep, voffB);
        PG8_WAIT_V(6); PG8_BAR;
    }
    for (;;) {
        const bool has_next = S.next(ui + 1, nxt);
        const char* nA = has_next ? (const char*)g.A + (size_t)nxt.pm * tstep + nxt.ko : cA; const char* nB = has_next ? (const char*)g.Bt + (size_t)nxt.pn * tstep + nxt.ko : cB;
        for (int t = 0; t < nt; t += 2) {
            const bool last = (t == nt - 2);
            const char* a1 = cA + (size_t)(t + 1) * kstep;
            const char* a2 = last ? nA : cA + (size_t)(t + 2) * kstep; const char* b2 = last ? nB : cB + (size_t)(t + 2) * kstep;
            const char* a3 = a2 + kstep; const char* b3 = b2 + kstep;
            if (last && has_next) S.a_ready(nxt);
            if constexpr (SP2) {
            PG8_LDB(B0, 0, 0); PG8_LDB(B1, 0, 1); PG8_SCHED; PG8_LDA(At, 0, 0); PG8_STAGE(PG8_SA(1, 1), a1 + hstep, voffA);
            PG8_WAIT_V(8); PG8_WAIT_L(0); PG8_BAR; PG8_MMA(0, 0, At, B0); PG8_MMA(0, 1, At, B1); PG8_BAR; PG8_SCHED;
            PG8_LDA(At, 0, 1); PG8_STAGE(PG8_SB(0, 0), b2, voffB); PG8_STAGE(PG8_SB(0, 1), b2 + hstep, voffB); PG8_STAGE(PG8_SA(0, 0), a2, voffA);
            PG8_WAIT_V(8); PG8_WAIT_L(0); PG8_BAR; PG8_MMA(1, 0, At, B0); PG8_MMA(1, 1, At, B1); PG8_BAR; PG8_SCHED;
            PG8_LDB(B0, 1, 0); PG8_LDB(B1, 1, 1); PG8_SCHED; PG8_LDA(At, 1, 0); PG8_STAGE(PG8_SA(0, 1), a2 + hstep, voffA);
            PG8_WAIT_V(8); PG8_WAIT_L(0); PG8_BAR; PG8_MMA(0, 0, At, B0); PG8_MMA(0, 1, At, B1); PG8_BAR; PG8_SCHED;
            PG8_LDA(At, 1, 1); PG8_STAGE(PG8_SB(1, 0), b3, voffB); PG8_STAGE(PG8_SB(1, 1), b3 + hstep, voffB); PG8_STAGE(PG8_SA(1, 0), a3, voffA);
            PG8_WAIT_V(8); PG8_WAIT_L(0); PG8_BAR; PG8_MMA(1, 0, At, B0); PG8_MMA(1, 1, At, B1); PG8_BAR; PG8_SCHED;
            } else {
            PG8_LDB(B0, 0, 0); PG8_SCHED; PG8_LDA(At, 0, 0); PG8_STAGE(PG8_SA(1, 1), a1 + hstep, voffA);
            PG8_WAIT_L(8); PG8_BAR; PG8_WAIT_L(0); PG8_MMA(0, 0, At, B0); PG8_BAR; PG8_SCHED;
            PG8_LDB(B1, 0, 1); PG8_STAGE(PG8_SB(0, 0), b2, voffB);
            PG8_BAR; PG8_WAIT_L(0); PG8_MMA(0, 1, At, B1); PG8_BAR;
            PG8_LDA(At, 0, 1); PG8_STAGE(PG8_SA(0, 0), a2, voffA);
            PG8_BAR; PG8_WAIT_L(0); PG8_MMA(1, 0, At, B0); PG8_BAR; PG8_SCHED;
            PG8_STAGE(PG8_SB(0, 1), b2 + hstep, voffB);
            PG8_WAIT_V(6); PG8_BAR; PG8_MMA(1, 1, At, B1); PG8_BAR;
            PG8_LDB(B0, 1, 0); PG8_SCHED; PG8_LDA(At, 1, 0); PG8_STAGE(PG8_SA(0, 1), a2 + hstep, voffA);
            PG8_WAIT_L(8); PG8_BAR; PG8_WAIT_L(0); PG8_MMA(0, 0, At, B0); PG8_BAR; PG8_SCHED;
            PG8_LDB(B1, 1, 1); PG8_STAGE(PG8_SB(1, 0), b3, voffB);
            PG8_BAR; PG8_WAIT_L(0); PG8_MMA(0, 1, At, B1); PG8_BAR;
            PG8_LDA(At, 1, 1); PG8_STAGE(PG8_SA(1, 0), a3, voffA);
            PG8_BAR; PG8_WAIT_L(0); PG8_MMA(1, 0, At, B0); PG8_BAR; PG8_SCHED;
            PG8_STAGE(PG8_SB(1, 1), b3 + hstep, voffB);
            PG8_WAIT_V(6); PG8_BAR; PG8_MMA(1, 1, At, B1); PG8_BAR;
            }
        }
        if constexpr (ALIGN_EPI) { if (wr == 0) PG8_BAR; }
        if constexpr (FP8) { asm volatile("s_nop 15\n\ts_nop 15" ::: "memory"); }
        if constexpr (!Epi::AFTER_DRAIN) { E(acc, cur, wr, wc, fr, fq); S.done(cur); }
        if (!has_next) break;
#pragma unroll
        for (int a = 0; a < 2; ++a)
#pragma unroll
            for (int b = 0; b < 2; ++b)
#pragma unroll
                for (int m = 0; m < 4; ++m)
#pragma unroll
                    for (int n = 0; n < 2; ++n) acc[a][b][m][n] = (f32x4){0.f, 0.f, 0.f, 0.f};
        cur = nxt; cA = nA; cB = nB; ++ui;
        if constexpr (ALIGN_EPI) { if (wr == 1) PG8_BAR; }
    }
    PG8_WAIT_V(0);
    if constexpr (!ALIGN_EPI) { if (wr == 0) PG8_BAR; }
    PG8_BAR;
    if constexpr (Epi::AFTER_DRAIN) { E.fused(acc, cur, wr, wc, fr, fq, lds, wid, lane); S.done(cur); }
#undef PG8_SA
#undef PG8_SB
#undef PG8_STAGE
#undef PG8_LDA
#undef PG8_LDB
#undef PG8_MMA
#undef PG8_WAIT_V
#undef PG8_WAIT_L
#undef PG8_BAR
#undef PG8_SCHED
}
}
namespace pg8 {
constexpr float C2F = 0.125f * 1.4426950408889634f;
constexpr float W8_SCALE = 512.0f, A8_SCALE = 8.0f, ACC8_INV = 1.0f / 4096.0f;
__device__ __forceinline__ unsigned pk4_fp8(float a, float b, float c, float d) {
    a = __builtin_amdgcn_fmed3f(a, -448.f, 448.f); b = __builtin_amdgcn_fmed3f(b, -448.f, 448.f); c = __builtin_amdgcn_fmed3f(c, -448.f, 448.f); d = __builtin_amdgcn_fmed3f(d, -448.f, 448.f);
    int w = 0; w = __builtin_amdgcn_cvt_pk_fp8_f32(a, b, w, false); w = __builtin_amdgcn_cvt_pk_fp8_f32(c, d, w, true); return (unsigned)w; }

typedef short pg8_v2s __attribute__((ext_vector_type(2)));
__device__ __forceinline__ unsigned pk4_fp8_w(float a, float b, float c, float d) {
    constexpr float LIM = 448.0f / W8_SCALE;
    a = __builtin_amdgcn_fmed3f(a, -LIM, LIM); b = __builtin_amdgcn_fmed3f(b, -LIM, LIM); c = __builtin_amdgcn_fmed3f(c, -LIM, LIM); d = __builtin_amdgcn_fmed3f(d, -LIM, LIM);
    pg8_v2s w = {0, 0}; w = __builtin_amdgcn_cvt_scalef32_pk_fp8_f32(w, a, b, 1.0f / W8_SCALE, false); w = __builtin_amdgcn_cvt_scalef32_pk_fp8_f32(w, c, d, 1.0f / W8_SCALE, true);
    return __builtin_bit_cast(unsigned, w); }

struct EpiProj {
    static constexpr bool PERM = true, AFTER_DRAIN = false;
    bf16_t* P; float* DT; float asc;
    __device__ __forceinline__ void operator()(const f32x4 (&acc)[2][2][4][2], const Unit& u, int wr, int wc, int fr_in, int fq_in) const {
        (void)fr_in; (void)fq_in; const int ln_ = (int)__builtin_amdgcn_mbcnt_hi(~0u, __builtin_amdgcn_mbcnt_lo(~0u, 0u)); int fr = ln_ & 15, fq = ln_ >> 4; asm volatile("" : "+v"(fr), "+v"(fq));
        const int row0 = u.pm * BM + wr * 64 + fr;
        if (u.pn == 22) {
            if (wc == 0 && fq < 2) {
#pragma unroll
                for (int ai = 0; ai < 2; ++ai)
#pragma unroll
                    for (int m = 0; m < 4; ++m) { float* p = DT + (size_t)(row0 + ai * HALF + m * 16) * 16 + 8 * fq;
                        *(f32x4*)p = acc[ai][0][m][0] * asc; *(f32x4*)(p + 4) = acc[ai][0][m][1] * asc; }
            }
            return;
        }
        const float sc = (u.pn == 10 || u.pn == 11 || u.pn == 16 || u.pn == 17) ? C2F * asc : asc;
        const int col0 = u.pn * BM + wc * 32 + 8 * fq;
#pragma unroll
        for (int ai = 0; ai < 2; ++ai)
#pragma unroll
            for (int m = 0; m < 4; ++m) { bf16_t* rowp = P + (size_t)(row0 + ai * HALF + m * 16) * 5632 + col0;
#pragma unroll
                for (int bj = 0; bj < 2; ++bj) { const f32x4 v0 = acc[ai][bj][m][0] * sc, v1 = acc[ai][bj][m][1] * sc;
                    u32x4 w; w.x = cvt_pk_bf16(v0[0], v0[1]); w.y = cvt_pk_bf16(v0[2], v0[3]); w.z = cvt_pk_bf16(v1[0], v1[1]); w.w = cvt_pk_bf16(v1[2], v1[3]);
                    *(u32x4*)(rowp + bj * HALF) = w; } }
    }
};
template <bool BASE16, bool NEXT8 = false> struct EpiResid {
    static constexpr bool PERM = true, AFTER_DRAIN = false;
    const void* base; bf16_t* out; const float* gate; float sc;
    unsigned char* U8; const float* gn; const float* scn; float* rowp; __attribute__((address_space(3))) float* red;
    __device__ __forceinline__ void operator()(const f32x4 (&acc)[2][2][4][2], const Unit& u, int wr, int wc, int fr_in, int fq_in) const {
        (void)fr_in; (void)fq_in; const int ln_ = (int)__builtin_amdgcn_mbcnt_hi(~0u, __builtin_amdgcn_mbcnt_lo(~0u, 0u)); int fr = ln_ & 15, fq = ln_ >> 4; asm volatile("" : "+v"(fr), "+v"(fq));
        const int row0 = u.pm * BM + wr * 64 + fr, col0 = u.pn * BM + wc * 32 + 8 * fq;
        f32x4 gv[2][2], gs[2][2];
#pragma unroll
        for (int bj = 0; bj < 2; ++bj)
#pragma unroll
            for (int n = 0; n < 2; ++n) { gv[bj][n] = *(const f32x4*)(gate + col0 + bj * HALF + n * 4) * sc;
                if (NEXT8) gs[bj][n] = *(const f32x4*)(gn + col0 + bj * HALF + n * 4) * (*(const f32x4*)(scn + col0 + bj * HALF + n * 4) + 1.0f) * A8_SCALE; }
#pragma unroll
        for (int ai = 0; ai < 2; ++ai) {
            u32x4 rb[4][2]; f32x4 fb[4][2][2];
#pragma unroll
            for (int m = 0; m < 4; ++m) { const size_t off = (size_t)(row0 + ai * HALF + m * 16) * 2048 + col0;
#pragma unroll
                for (int bj = 0; bj < 2; ++bj) {
                    if (BASE16) rb[m][bj] = *(const u32x4*)((const bf16_t*)base + off + bj * HALF);
                    else { fb[m][bj][0] = *(const f32x4*)((const float*)base + off + bj * HALF); fb[m][bj][1] = *(const f32x4*)((const float*)base + off + bj * HALF + 4); } } }
#pragma unroll
            for (int m = 0; m < 4; ++m) { const size_t off = (size_t)(row0 + ai * HALF + m * 16) * 2048 + col0; float ss = 0.f;
#pragma unroll
                for (int bj = 0; bj < 2; ++bj) { f32x4 b0, b1;
                    if (BASE16) { const u32x4 r = rb[m][bj];
                        b0 = (f32x4){__uint_as_float(r.x << 16), __uint_as_float(r.x & 0xffff0000u), __uint_as_float(r.y << 16), __uint_as_float(r.y & 0xffff0000u)};
                        b1 = (f32x4){__uint_as_float(r.z << 16), __uint_as_float(r.z & 0xffff0000u), __uint_as_float(r.w << 16), __uint_as_float(r.w & 0xffff0000u)}; }
                    else { b0 = fb[m][bj][0]; b1 = fb[m][bj][1]; }
                    const f32x4 o0 = b0 + gv[bj][0] * acc[ai][bj][m][0], o1 = b1 + gv[bj][1] * acc[ai][bj][m][1];
                    u32x4 w; w.x = cvt_pk_bf16(o0[0], o0[1]); w.y = cvt_pk_bf16(o0[2], o0[3]); w.z = cvt_pk_bf16(o1[0], o1[1]); w.w = cvt_pk_bf16(o1[2], o1[3]);
                    *(u32x4*)(out + off + bj * HALF) = w;
                    if (NEXT8) { typedef unsigned u32x2 __attribute__((ext_vector_type(2)));
                        ss += (o0[0] * o0[0] + o0[1] * o0[1]) + (o0[2] * o0[2] + o0[3] * o0[3]) + (o1[0] * o1[0] + o1[1] * o1[1]) + (o1[2] * o1[2] + o1[3] * o1[3]);
                        const f32x4 q0 = o0 * gs[bj][0], q1 = o1 * gs[bj][1]; u32x2 q; q.x = pk4_fp8(q0[0], q0[1], q0[2], q0[3]); q.y = pk4_fp8(q1[0], q1[1], q1[2], q1[3]);
                        *(u32x2*)(U8 + off + bj * HALF) = q; } }
                if (NEXT8) { ss += __shfl_xor(ss, 16); ss += __shfl_xor(ss, 32);
                    if (fq == 0) red[wc * 256 + wr * 64 + fr + ai * HALF + m * 16] = ss; } }
            asm volatile("" ::: "memory"); }
        if (NEXT8) { __syncthreads();
            int t = (int)threadIdx.x; asm volatile("" : "+v"(t));
            if (t < 256) rowp[(size_t)(u.pm * BM + t) * 8 + u.pn] = (red[t] + red[256 + t]) + (red[512 + t] + red[768 + t]); }
    }
};
__device__ __forceinline__ float silu_mul(float a, float b) { return a * b * __builtin_amdgcn_rcpf(1.0f + __builtin_amdgcn_exp2f(-1.4426950408889634f * a)); }
template <int TPE, int LDC, bool NORM = false> struct EpiSwiGLU {
    static constexpr bool PERM = true, AFTER_DRAIN = false;
    unsigned char* O; const float* rowp; const float* bias;
    __device__ __forceinline__ void operator()(const f32x4 (&acc)[2][2][4][2], const Unit& u, int wr, int wc, int fr_in, int fq_in) const {
        (void)fr_in; (void)fq_in; const int ln_ = (int)__builtin_amdgcn_mbcnt_hi(~0u, __builtin_amdgcn_mbcnt_lo(~0u, 0u)); int fr = ln_ & 15, fq = ln_ >> 4; asm volatile("" : "+v"(fr), "+v"(fq));
        const int row0 = u.po * BM + wr * 64 + fr, pl = u.pn % TPE, col0 = pl * HALF + wc * 32 + 8 * fq;
        typedef unsigned u32x2 __attribute__((ext_vector_type(2)));
        f32x4 ba[2], bb[2];
        if (NORM) { const float* bp = bias + u.pn * BM + wc * 32 + 8 * fq; ba[0] = *(const f32x4*)bp; ba[1] = *(const f32x4*)(bp + 4); bb[0] = *(const f32x4*)(bp + HALF); bb[1] = *(const f32x4*)(bp + HALF + 4); }
#pragma unroll
        for (int ai = 0; ai < 2; ++ai) {
            float rsv[4];
            if (NORM) { f32x4 pa[4], pb[4];
#pragma unroll
                for (int m = 0; m < 4; ++m) { const float* rp = rowp + (size_t)(u.pm * BM + wr * 64 + fr + ai * HALF + m * 16) * 8; pa[m] = *(const f32x4*)rp; pb[m] = *(const f32x4*)(rp + 4); }
#pragma unroll
                for (int m = 0; m < 4; ++m) rsv[m] = ACC8_INV * __builtin_amdgcn_rsqf((((pa[m][0] + pa[m][1]) + (pa[m][2] + pa[m][3])) + ((pb[m][0] + pb[m][1]) + (pb[m][2] + pb[m][3]))) * (1.0f / 2048.0f) + 1e-6f); }
#pragma unroll
            for (int m = 0; m < 4; ++m) { unsigned char* orow = O + (size_t)(row0 + ai * HALF + m * 16) * LDC + col0;
                const float rs = NORM ? rsv[m] : ACC8_INV;
                u32x2 w;
                { f32x4 a0 = acc[ai][0][m][0] * rs, b0 = acc[ai][1][m][0] * rs; if (NORM) { a0 += ba[0]; b0 += bb[0]; } b0 *= A8_SCALE;
                  w.x = pk4_fp8(silu_mul(a0[0], b0[0]), silu_mul(a0[1], b0[1]), silu_mul(a0[2], b0[2]), silu_mul(a0[3], b0[3])); }
                asm volatile("" : "+v"(w.x));
                { f32x4 a1 = acc[ai][0][m][1] * rs, b1 = acc[ai][1][m][1] * rs; if (NORM) { a1 += ba[1]; b1 += bb[1]; } b1 *= A8_SCALE;
                  w.y = pk4_fp8(silu_mul(a1[0], b1[0]), silu_mul(a1[1], b1[1]), silu_mul(a1[2], b1[2]), silu_mul(a1[3], b1[3])); }
                *(u32x2*)orow = w; asm volatile("" ::: "memory"); } }
    }
};
template <int TPE, int LDC> struct EpiPlain {
    static constexpr bool PERM = true, AFTER_DRAIN = false;
    bf16_t* O;
    __device__ __forceinline__ void operator()(const f32x4 (&acc)[2][2][4][2], const Unit& u, int wr, int wc, int fr_in, int fq_in) const {
        (void)fr_in; (void)fq_in; const int ln_ = (int)__builtin_amdgcn_mbcnt_hi(~0u, __builtin_amdgcn_mbcnt_lo(~0u, 0u)); int fr = ln_ & 15, fq = ln_ >> 4; asm volatile("" : "+v"(fr), "+v"(fq));
        const int row0 = u.pm * BM + wr * 64 + fr, pl = u.pn % TPE, col0 = pl * BM + wc * 32 + 8 * fq;
#pragma unroll
        for (int ai = 0; ai < 2; ++ai)
#pragma unroll
            for (int m = 0; m < 4; ++m) { bf16_t* rowp = O + (size_t)(row0 + ai * HALF + m * 16) * LDC + col0;
#pragma unroll
                for (int bj = 0; bj < 2; ++bj) { const f32x4 v0 = acc[ai][bj][m][0] * ACC8_INV, v1 = acc[ai][bj][m][1] * ACC8_INV;
                    u32x4 w; w.x = cvt_pk_bf16(v0[0], v0[1]); w.y = cvt_pk_bf16(v0[2], v0[3]); w.z = cvt_pk_bf16(v1[0], v1[1]); w.w = cvt_pk_bf16(v1[2], v1[3]);
                    *(u32x4*)(rowp + bj * HALF) = w; } }
    }
};
struct EpiTail {
    static constexpr bool PERM = true, AFTER_DRAIN = false;
    bf16_t* T;
    __device__ __forceinline__ void operator()(const f32x4 (&acc)[2][2][4][2], const Unit& u, int wr, int wc, int fr_in, int fq_in) const {
        (void)fr_in; (void)fq_in; const int ln_ = (int)__builtin_amdgcn_mbcnt_hi(~0u, __builtin_amdgcn_mbcnt_lo(~0u, 0u)); int fr = ln_ & 15, fq = ln_ >> 4; asm volatile("" : "+v"(fr), "+v"(fq));
        bf16_t* base = T + (size_t)u.po * 65536 + (size_t)(wr * 64 + fr) * 256 + wc * 32 + 8 * fq;
#pragma unroll
        for (int ai = 0; ai < 2; ++ai)
#pragma unroll
            for (int m = 0; m < 4; ++m) { bf16_t* rowp = base + (size_t)(ai * HALF + m * 16) * 256;
#pragma unroll
                for (int bj = 0; bj < 2; ++bj) { const f32x4 v0 = acc[ai][bj][m][0] * ACC8_INV, v1 = acc[ai][bj][m][1] * ACC8_INV;
                    u32x4 w; w.x = cvt_pk_bf16(v0[0], v0[1]); w.y = cvt_pk_bf16(v0[2], v0[3]); w.z = cvt_pk_bf16(v1[0], v1[1]); w.w = cvt_pk_bf16(v1[2], v1[3]);
                    *(u32x4*)(rowp + bj * HALF) = w; } }
    }
};
__device__ __forceinline__ void moe_unit_map(const PG8_LAS int* tab, int tpe, int L, int& pm, int& e_out, int& j_out) {
    const int nwg = tab[8] * tpe;
    int wgid = L; { const int q = nwg / NXCD, r = nwg % NXCD, xcd = wgid % NXCD, off = wgid / NXCD; wgid = (xcd < r ? xcd * (q + 1) : r * (q + 1) + (xcd - r) * q) + off; }
    int e = 0;
#pragma unroll
    for (int k = 1; k < 8; ++k) e += (wgid >= tab[k] * tpe) ? 1 : 0;
    const int f = tab[e], nt = tab[e + 1] - f, idx = wgid - f * tpe;
    pm = f + idx % nt; e_out = e; j_out = idx / nt;
}
struct GroupedOrder {
    static __device__ __forceinline__ void build_full(PG8_LAS int* list, const PG8_LAS int* tab, int tpe, int lfull, int G, int c, int i) {
        const int nwg = tab[8] * tpe, lim = nwg < lfull ? nwg : lfull; const int L = i * G + c; int pm = -1, pn = 0;
        if (L < lim) { int e, j; moe_unit_map(tab, tpe, L, pm, e, j); pn = e * tpe + j; }
        list[4 * i] = pm; list[4 * i + 1] = pn; list[4 * i + 2] = 0; list[4 * i + 3] = pm;
    }
    static __device__ __forceinline__ void build_tail(PG8_LAS int* list, const PG8_LAS int* tab, int tpe, int lfull, int kparts, int kob, int G, int c, int i) {
        const int nwg = tab[8] * tpe, ntail = nwg > lfull ? nwg - lfull : 0; const int S = i * G + c; int pm = -1, pn = 0, ko = 0, po = 0;
        if (S < ntail * kparts) { const int q = S % ntail, kp = S / ntail; int e, j; moe_unit_map(tab, tpe, lfull + q, pm, e, j); pn = e * tpe + j; ko = kp * kob; po = kp * 64 + q; }
        list[4 * i] = pm; list[4 * i + 1] = pn; list[4 * i + 2] = ko; list[4 * i + 3] = po;
    }
    const PG8_LAS int* list;
    static __device__ __forceinline__ void build(PG8_LAS int* list, const PG8_LAS int* tab, int tpe, int ksp, int kob, int abase, int G, int c, int i) {
        const int tpf = tpe * ksp, nwg = tab[8] * tpf; const long L = (long)i * G + c; int pm = -1, pn = 0, ko = 0, po = 0;
        if (L < nwg) {
            int wgid = (int)L; { const int q = nwg / NXCD, r = nwg % NXCD, xcd = wgid % NXCD, off = wgid / NXCD; wgid = (xcd < r ? xcd * (q + 1) : r * (q + 1) + (xcd - r) * q) + off; }
            int e = 0;
#pragma unroll
            for (int k = 1; k < 8; ++k) e += (wgid >= tab[k] * tpf) ? 1 : 0;
            const int f = tab[e], nt = tab[e + 1] - f, idx = wgid - f * tpf, rest = idx / nt, loc = idx % nt;
            po = f + loc; pm = abase ? e * abase + loc : po; pn = e * tpe + rest % tpe; ko = (rest / tpe) * kob; }
        list[4 * i] = pm; list[4 * i + 1] = pn; list[4 * i + 2] = ko; list[4 * i + 3] = po;
    }
    __device__ __forceinline__ bool next(int i, Unit& u) const {
        if (i >= 32) return false;
        const int pm = __builtin_amdgcn_readfirstlane(list[4 * i]); if (pm < 0) return false;
        u.pm = pm; u.pn = __builtin_amdgcn_readfirstlane(list[4 * i + 1]); u.ko = __builtin_amdgcn_readfirstlane(list[4 * i + 2]); u.po = __builtin_amdgcn_readfirstlane(list[4 * i + 3]); return true;
    }
    __device__ __forceinline__ void a_ready(const Unit&) const {}
    __device__ __forceinline__ void done(const Unit&) const {}
};
}
constexpr int NTOK = 8192, DM = 2048, NMOD = 12288, NPROJ = 5632, NPROJ_T = 5888, NIN = 5648;
constexpr int FFD = 5632, FFE = 7168, NEXP = 8, MAXROWS = 18432;
constexpr int C_Z = 0, C_XBC = 1024, C_MQ = 2560, C_MK = 3072, C_MV = 3584, C_DQ = 4096, C_DK = 4608, C_DV = 5120;
constexpr float EPSF = 1e-6f, LOG2E = 1.4426950408889634f;
constexpr size_t MiB = 1u << 20;
constexpr size_t WS_CTL = 0, CTL_ZERO_BYTES = 1 * MiB;
constexpr size_t WS_MODP = 1 * MiB, WS_MOD = 2 * MiB, WS_KM = 6 * MiB, WS_ROUTE = 3 * MiB + 256 * 1024, WS_DT = 4 * MiB, WS_DTV = 4 * MiB + 512 * 1024, WS_ACS = 5 * MiB;
constexpr size_t WS_BIASU = 7 * MiB, WS_ROWP = 7 * MiB + 256 * 1024;
constexpr size_t WS_WIN = 8 * MiB, WS_WOUT = 56 * MiB, WS_W13 = 72 * MiB, WS_W2 = 116 * MiB, WS_W13E = 138 * MiB, WS_W2E = 586 * MiB;
constexpr size_t WS_H = 810 * MiB, WS_PROJ = 842 * MiB, WS_XC = 930 * MiB, WS_YRAW = 954 * MiB, WS_MOBA = 986 * MiB, WS_DIFF = 994 * MiB, WS_Y = 1010 * MiB, WS_XA = 1042 * MiB;
constexpr size_t WS_XG8S = (138 + 224) * MiB;
constexpr size_t WS_YG2 = (1106 + 128) * MiB;
constexpr size_t WS_G = 1106 * MiB, WS_XG = 1358 * MiB, WS_YG = 1430 * MiB, WS_SST = 1502 * MiB, WS_HPREV = 1518 * MiB, WS_END = 1534 * MiB;
static_assert(WS_WIN + 2ull * NPROJ_T * DM * 2 <= WS_WOUT && WS_WOUT + 2ull * DM * DM * 2 <= WS_W13 && WS_W13 + 2ull * FFD * DM * 2 <= WS_W2 && WS_W2 + (size_t)DM * FFD * 2 <= WS_W13E, "ws map 1");
static_assert(WS_W13E + 8ull * 2 * FFE * DM * 2 <= WS_W2E && WS_W2E + 8ull * DM * FFE * 2 <= WS_H && WS_PROJ + (size_t)NTOK * NPROJ * 2 <= WS_XC && WS_G + (size_t)MAXROWS * FFE * 2 <= WS_XG, "ws map 2");
static_assert(WS_XG + (size_t)MAXROWS * DM * 2 <= WS_YG && WS_YG + (size_t)MAXROWS * DM * 2 <= WS_SST, "ws map 3");
constexpr int CW_TMO = 0, CW_CODE = 1, CW_CNT = 64, CW_Q = 128, CW_BAR = 4096;
constexpr int RING_OFF = 0, RING_BYTES = 131072, LDSCTL_OFF = 139264, LDS_BYTES = 147456;
constexpr int NWAVES = 8, NPHASE = 25;

#define GAS __attribute__((address_space(1)))
#define LAS __attribute__((address_space(3)))
typedef unsigned short bf16;
typedef unsigned v4u __attribute__((ext_vector_type(4)));
typedef unsigned v2u __attribute__((ext_vector_type(2)));
typedef float f32x4 __attribute__((ext_vector_type(4)));
#define RLX_AGENT __ATOMIC_RELAXED, __HIP_MEMORY_SCOPE_AGENT
#define LDS_WAIT() asm volatile("s_waitcnt lgkmcnt(0)" ::: "memory")
__device__ __forceinline__ unsigned f2bf(float f) { unsigned u = __builtin_bit_cast(unsigned, f); return (u + 0x7fffu + ((u >> 16) & 1u)) >> 16; }
__device__ __forceinline__ unsigned pk2(float lo, float hi) { return f2bf(lo) | (f2bf(hi) << 16); }
__device__ __forceinline__ float bflo(unsigned w) { return __uint_as_float(w << 16); }
__device__ __forceinline__ float bfhi(unsigned w) { return __uint_as_float(w & 0xffff0000u); }
__device__ __forceinline__ float bf1(bf16 b) { return __uint_as_float((unsigned)b << 16); }
__device__ __forceinline__ float wave_sum(float v) {
#pragma unroll
    for (int o = 1; o < 64; o <<= 1) v += __shfl_xor(v, o);
    return v;
}
__device__ __forceinline__ float wave_max(float v) {
#pragma unroll
    for (int o = 1; o < 64; o <<= 1) v = fmaxf(v, __shfl_xor(v, o));
    return v;
}
__device__ __forceinline__ float siluf(float a) { return a / (1.0f + __expf(-a)); }
#define XB_TMO      128
#define XB_XCNT(j)  (256  + 64 * (j))
#define XB_XSUB(j)  (1280 + 64 * (j))
#define XB_XGEN(j)  (2304 + 64 * (j))
#define XB_TOP      3328
#define XB_TOPGEN   3392
#define XCD_BAR_WORDS 3456
#define XB_SPIN_CAP (1u << 22)

__device__ __forceinline__ unsigned xb_ld(unsigned* p)              { return __hip_atomic_load(p, __ATOMIC_RELAXED, __HIP_MEMORY_SCOPE_AGENT); }
__device__ __forceinline__ unsigned xb_add(unsigned* p, unsigned v) { return __hip_atomic_fetch_add(p, v, __ATOMIC_RELAXED, __HIP_MEMORY_SCOPE_AGENT); }
__device__ __forceinline__ unsigned xb_xcc_id() { return (unsigned)__builtin_amdgcn_s_getreg((3 << 11) | 20) & 0xFu; }
#define XB_SPIN(cond, bar) do { unsigned _sp = 0; while (cond) { __builtin_amdgcn_s_sleep(1); \
    if ((++_sp & 255u) == 0u) { if (xb_ld(&(bar)[XB_TMO])) break; if (_sp > XB_SPIN_CAP) { atomicAdd(&(bar)[XB_TMO], 1u); break; } } } } while (0)

struct XcdBarrier {
    unsigned* bar; unsigned x;
    volatile LAS unsigned* st;
};

__device__ __forceinline__ XcdBarrier xcd_barrier_post(unsigned* bar, volatile LAS unsigned* st) {
    XcdBarrier b; b.bar = bar; b.x = xb_xcc_id(); b.st = st;
    if (threadIdx.x == 0) (void)xb_add(&bar[XB_XCNT(b.x)], 1u);
    return b;
}
__device__ __forceinline__ void xcd_barrier_complete(unsigned* bar, unsigned x, unsigned& nloc, unsigned& nx) {
    const unsigned G = gridDim.x * gridDim.y * gridDim.z;
    unsigned sum, cnt, mine, sp = 0u;
    for (;;) {
        sum = 0u; cnt = 0u; mine = 0u;
#pragma unroll
        for (unsigned j = 0; j < 16; ++j) { const unsigned c = xb_ld(&bar[XB_XCNT(j)]); sum += c; cnt += (c > 0u) ? 1u : 0u; mine = (j == x) ? c : mine; }
        if (sum == G) break;
        __builtin_amdgcn_s_sleep(1);
        if ((++sp & 255u) == 0u) { if (xb_ld(&bar[XB_TMO])) break; if (sp > XB_SPIN_CAP) { atomicAdd(&bar[XB_TMO], 1u); break; } }
    }
    nloc = mine > 0u ? mine : 1u; nx = cnt > 0u ? cnt : 1u;
}

__device__ __forceinline__ void xcd_barrier(const XcdBarrier& b) {
    asm volatile("s_waitcnt vmcnt(0)" ::: "memory");
    __syncthreads();
    if (threadIdx.x == 0) {
        unsigned* bar = b.bar;
        __builtin_amdgcn_s_waitcnt(0);
        unsigned nloc = b.st[0], nx = b.st[1];
        if (nloc == 0u) { xcd_barrier_complete(bar, b.x, nloc, nx); b.st[0] = nloc; b.st[1] = nx; }
        const unsigned old = xb_add(&bar[XB_XSUB(b.x)], 1u);
        const unsigned gen = old / nloc;
        if (old + 1u == (gen + 1u) * nloc) {
            __builtin_amdgcn_fence(__ATOMIC_RELEASE, "agent");
            asm volatile("s_waitcnt vmcnt(0)" ::: "memory");
            const unsigned og = xb_add(&bar[XB_TOP], 1u);
            const unsigned tg = og / nx;
            if (og + 1u == (tg + 1u) * nx) xb_add(&bar[XB_TOPGEN], 1u);
            else XB_SPIN(xb_ld(&bar[XB_TOPGEN]) == tg, bar);
            __builtin_amdgcn_fence(__ATOMIC_ACQUIRE, "agent");
            xb_add(&bar[XB_XGEN(b.x)], 1u);
            asm volatile("s_waitcnt vmcnt(0)" ::: "memory");
        } else {
            XB_SPIN(xb_ld(&bar[XB_XGEN(b.x)]) == gen, bar);
            __builtin_amdgcn_fence(__ATOMIC_ACQUIRE, "agent");
            asm volatile("s_waitcnt vmcnt(0)" ::: "memory");
        }
    }
    __syncthreads();
}
#include <hip/hip_bf16.h>
#include <cmath>
namespace attn_body {
using bf16=__hip_bfloat16;
typedef float f32x4a __attribute__((ext_vector_type(4))); typedef int i32x4a __attribute__((ext_vector_type(4)));
using bf16x8=__attribute__((ext_vector_type(8)))short;
using s16x4=__attribute__((ext_vector_type(4)))short;
using f32x16=__attribute__((ext_vector_type(16)))float;
using u32x4=__attribute__((ext_vector_type(4)))unsigned;
constexpr int SEQ=8192,D=64,DM=5632;
constexpr int NW=8,QBLK=32,QB=QBLK*NW,KVBLK=64,NQB=SEQ/QB;
__device__ __forceinline__ int crow(int r,int hi){return (r&3)+8*(r>>2)+4*hi;}
#define SBAR() __builtin_amdgcn_sched_barrier(0)
__device__ __forceinline__ void cmask(f32x16&p0,f32x16&p1,int jb,int qrel,int hi){
  const float NEG=-INFINITY; int kb=64*jb+4*hi;
  #pragma unroll
  for(int r=0;r<16;++r){int kv=kb+(r&3)+8*(r>>2); if(kv>qrel)p0[r]=NEG; if(kv+32>qrel)p1[r]=NEG;}
}

constexpr int NSLOT=3, SLOTB=8192;
constexpr int LDS_K=0, LDS_V=NSLOT*SLOTB, LDS_WS=2*NSLOT*SLOTB, LDS_OST=LDS_WS+NW*64*4, LDS_BYTES=LDS_OST+NW*4096;
constexpr float C2=0.125f*1.4426950408889634f;
__device__ __forceinline__ void glds16(const void*gsrc,unsigned lds_dst){unsigned keep;
  asm volatile("s_mov_b32 %0, m0\n\ts_mov_b32 m0, %2\n\ts_nop 0\n\tglobal_load_lds_dwordx4 %1, off\n\ts_mov_b32 m0, %0":"=&s"(keep):"v"(gsrc),"s"(lds_dst):"memory");}
__device__ __forceinline__ float max3f(float a,float b,float c){float r;asm("v_max3_f32 %0, %1, %2, %3":"=v"(r):"v"(a),"v"(b),"v"(c));return r;}
__device__ __forceinline__ float max2f(float a,float b){float r;asm("v_max_f32_e32 %0, %1, %2":"=v"(r):"v"(a),"v"(b));return r;}
__device__ __forceinline__ float fadd_s(float a,float b){float r;asm("v_add_f32_e32 %0, %1, %2":"=v"(r):"v"(a),"v"(b));return r;}
__device__ __forceinline__ float fsub_s(float a,float b){float r;asm("v_sub_f32_e32 %0, %1, %2":"=v"(r):"v"(a),"v"(b));return r;}
typedef float f32x2_t __attribute__((ext_vector_type(2))); typedef __bf16 bf16x2_t __attribute__((ext_vector_type(2)));
__device__ __forceinline__ unsigned cvtpk_s(float lo,float hi){f32x2_t v={lo,hi};bf16x2_t b=__builtin_convertvector(v,bf16x2_t);return __builtin_bit_cast(unsigned,b);}
#define WAIT_BAR(N) asm volatile("s_waitcnt vmcnt(" #N ") lgkmcnt(0)\n\ts_barrier":::"memory")

__device__ __forceinline__ void qkt(f32x16&p0,f32x16&p1,const char*Kslot,const bf16x8*qr,const f32x16&negm,int r32,int hi){
  const char*kb=Kslot+hi*1024+r32*16;
  #pragma unroll
  for(int d0=0;d0<4;++d0){
    const bf16x8 b0=*reinterpret_cast<const bf16x8*>(kb+d0*2048);
    const bf16x8 b1=*reinterpret_cast<const bf16x8*>(kb+d0*2048+512);
    if(d0==0){p0=__builtin_amdgcn_mfma_f32_32x32x16_bf16(b0,qr[0],negm,0,0,0);p1=__builtin_amdgcn_mfma_f32_32x32x16_bf16(b1,qr[0],negm,0,0,0);}
    else{p0=__builtin_amdgcn_mfma_f32_32x32x16_bf16(b0,qr[d0],p0,0,0,0);p1=__builtin_amdgcn_mfma_f32_32x32x16_bf16(b1,qr[d0],p1,0,0,0);}}
}
typedef __attribute__((address_space(3))) const char* lds_cptr;
typedef short v4i16_t __attribute__((ext_vector_type(4)));
__device__ __forceinline__ void kload8(bf16x8*kf,lds_cptr kp){
  kf[0]=*(const __attribute__((address_space(3))) bf16x8*)(kp);      kf[1]=*(const __attribute__((address_space(3))) bf16x8*)(kp+512);
  kf[2]=*(const __attribute__((address_space(3))) bf16x8*)(kp+2048); kf[3]=*(const __attribute__((address_space(3))) bf16x8*)(kp+2560);
  kf[4]=*(const __attribute__((address_space(3))) bf16x8*)(kp+4096); kf[5]=*(const __attribute__((address_space(3))) bf16x8*)(kp+4608);
  kf[6]=*(const __attribute__((address_space(3))) bf16x8*)(kp+6144); kf[7]=*(const __attribute__((address_space(3))) bf16x8*)(kp+6656);
}
__device__ __forceinline__ void kload2(bf16x8*kf,lds_cptr kp,int j){ kf[2*j]=*(const __attribute__((address_space(3))) bf16x8*)(kp+j*2048); kf[2*j+1]=*(const __attribute__((address_space(3))) bf16x8*)(kp+j*2048+512); }
__device__ __forceinline__ s16x4 vtr(lds_cptr p){ return __builtin_bit_cast(s16x4,__builtin_amdgcn_ds_read_tr16_b64_v4i16((__attribute__((address_space(3))) v4i16_t*)p)); }
__device__ __forceinline__ float rowmax(const f32x16&p0,const f32x16&p1){
  float a=max3f(p0[0],p0[1],p1[0]),b=max3f(p0[2],p0[3],p1[1]);a=max3f(a,p1[2],p1[3]);
  #pragma unroll
  for(int r=4;r<16;r+=4){a=max3f(a,p0[r],p0[r+1]);b=max3f(b,p0[r+2],p0[r+3]);a=max3f(a,p1[r],p1[r+1]);b=max3f(b,p1[r+2],p1[r+3]);}
  const float m=max2f(a,b);
  auto rr=__builtin_amdgcn_permlane32_swap(__float_as_uint(m),__float_as_uint(m),false,false);
  return max2f(__uint_as_float(rr[0]),__uint_as_float(rr[1]));
}
__device__ __forceinline__ void pv(f32x16*o,int vb,bf16x8 pa0,bf16x8 pa1,bf16x8 pa2,bf16x8 pa3){
  #pragma unroll
  for(int d0=0;d0<2;++d0){s16x4 lo[4],hi[4];
    #pragma unroll
    for(int ks=0;ks<4;++ks){
      asm volatile("ds_read_b64_tr_b16 %0,%1 offset:%c2":"=&v"(lo[ks]):"v"(vb),"i"(d0*4096+ks*1024):"memory");
      asm volatile("ds_read_b64_tr_b16 %0,%1 offset:%c2":"=&v"(hi[ks]):"v"(vb),"i"(d0*4096+ks*1024+512):"memory");}
    asm volatile("s_waitcnt lgkmcnt(0)":::"memory");SBAR();
    #define PK(k) (bf16x8){lo[k][0],lo[k][1],lo[k][2],lo[k][3],hi[k][0],hi[k][1],hi[k][2],hi[k][3]}
    o[d0]=__builtin_amdgcn_mfma_f32_32x32x16_bf16(pa0,PK(0),o[d0],0,0,0);
    o[d0]=__builtin_amdgcn_mfma_f32_32x32x16_bf16(pa1,PK(1),o[d0],0,0,0);
    o[d0]=__builtin_amdgcn_mfma_f32_32x32x16_bf16(pa2,PK(2),o[d0],0,0,0);
    o[d0]=__builtin_amdgcn_mfma_f32_32x32x16_bf16(pa3,PK(3),o[d0],0,0,0);
    #undef PK
  }
}

#ifndef ATTN_STORE16
#define ATTN_STORE16(p,v) (*(u32x4*)(p)=(v))
#endif
template<int THRL,int MODE> __device__ __forceinline__ void attn_unit(int qb,const bf16*Qh,const bf16*__restrict__ Kh,const bf16*__restrict__ Vh,bf16*Oh,int opitch,char*shm,
    const __attribute__((address_space(3))) int*posL,const __attribute__((address_space(3))) int*kmaxL,const __attribute__((address_space(3))) float*biasH,const __attribute__((address_space(3))) float*kmL){
  int tid_=threadIdx.x; asm volatile("":"+v"(tid_));
  const int tid=tid_,lane=tid&63,r32=lane&31,hi=lane>>5; const int wid=__builtin_amdgcn_readfirstlane(tid>>6);
  const int q0=qb*QB;
  const bf16*Qw=Qh+(long)(q0+wid*QBLK)*DM;
  const unsigned lds0=(unsigned)(uintptr_t)shm;
  float*wsf=(float*)(shm+LDS_WS)+wid*64;
  const bf16*ksrc=Kh+(long)lane*DM+wid*8;
  const bf16*vsrc=Vh+(long)(16*(wid&3)+(lane>>2))*DM+(wid>>2)*32+(lane&3)*8;
  const unsigned kdst=lds0+LDS_K+wid*1024, vdst=lds0+LDS_V+wid*1024;
  #define DMA_K(t,slot) glds16(ksrc+(long)(t)*KVBLK*DM,(unsigned)__builtin_amdgcn_readfirstlane(kdst+(slot)))
  #define DMA_V(t,slot) glds16(vsrc+(long)(t)*KVBLK*DM,(unsigned)__builtin_amdgcn_readfirstlane(vdst+(slot)))
  const int vb0=(int)(lds0+LDS_V)+((lane>>4)&1)*32+(lane&3)*8+(4*hi+((lane&15)>>2))*64;
  const char*Kbase=shm+LDS_K; bf16x8 kf[8];
  const lds_cptr shm3=(lds_cptr)shm; const lds_cptr kp0=shm3+LDS_K+hi*1024+r32*16; const lds_cptr vp0=shm3+LDS_V+((lane>>4)&1)*32+(lane&3)*8+(4*hi+((lane&15)>>2))*64;
  const int NT=(q0+QB)/KVBLK;
  DMA_K(0,0);DMA_V(0,0);DMA_K(1,SLOTB);
  bf16x8 qr[4];
  #pragma unroll
  for(int d0=0;d0<4;++d0)qr[d0]=*reinterpret_cast<const bf16x8*>(&Qw[(long)r32*DM+d0*16+hi*8]);
  const int qrel=wid*QBLK+r32;
  const int qpos=posL[q0+qrel];
  int tnear;
  { int qmn=qpos; _Pragma("unroll") for(int o_=1;o_<64;o_<<=1){ const int x_=__shfl_xor(qmn,o_); qmn=x_<qmn?x_:qmn; }
    const int NT_=(q0+QB)/KVBLK;
    const bool c0_=(lane<NT_)&&(qmn-kmaxL[lane]<128), c1_=(lane+64<NT_)&&(qmn-kmaxL[(lane+64)&127]<128);
    const unsigned long long b0_=__ballot(c0_), b1_=__ballot(c1_);
    const int tn=b0_?(__ffsll((long long)b0_)-1):(b1_?(64+__ffsll((long long)b1_)-1):NT_); tnear=__builtin_amdgcn_readfirstlane(tn); }
  unsigned selmask=0xffffffffu;
  if(MODE==1){ float qf[32];
    _Pragma("unroll") for(int d0=0;d0<4;++d0){ _Pragma("unroll") for(int j=0;j<8;++j) qf[8*d0+j]=__uint_as_float(((unsigned)(unsigned short)qr[d0][j])<<16); }
    float v0=-INFINITY,v1=-INFINITY,v2=-INFINITY; int i0=0,i1=0,i2=0;
    for(int j=0;j<qb;++j){ const __attribute__((address_space(3))) float*kp=kmL+j*64+8*hi; float s_=0.f;
      _Pragma("unroll") for(int d0=0;d0<4;++d0){ const f32x4a a_=*(const __attribute__((address_space(3))) f32x4a*)(kp+16*d0), b_=*(const __attribute__((address_space(3))) f32x4a*)(kp+16*d0+4);
        s_+=qf[8*d0+0]*a_[0]+qf[8*d0+1]*a_[1]+qf[8*d0+2]*a_[2]+qf[8*d0+3]*a_[3]+qf[8*d0+4]*b_[0]+qf[8*d0+5]*b_[1]+qf[8*d0+6]*b_[2]+qf[8*d0+7]*b_[3]; }
      s_+=__shfl_xor(s_,32);
      if(s_>v0){v2=v1;i2=i1;v1=v0;i1=i0;v0=s_;i0=j;} else if(s_>v1){v2=v1;i2=i1;v1=s_;i1=j;} else if(s_>v2){v2=s_;i2=j;} }
    selmask=1u<<qb; if(qb>=1)selmask|=1u<<i0; if(qb>=2)selmask|=1u<<i1; if(qb>=3)selmask|=1u<<i2; }
  float mhat=0.f,l_reg=0.f;f32x16 o[2];o[0]=f32x16{};o[1]=f32x16{};f32x16 negm=f32x16{};asm volatile("":"+v"(negm));
  #define CMASK(P0,P1,t) do{int jb_=(t)-(NT-4); if(jb_>=0)cmask(P0,P1,jb_,qrel,hi);}while(0)
  #define BIAS(P0,P1,t) do{ if((t)>=tnear){ const __attribute__((address_space(3))) int*pp_=posL+64*(t)+4*hi; \
      _Pragma("unroll") for(int g_=0;g_<4;++g_){ const i32x4a ka_=*(const __attribute__((address_space(3))) i32x4a*)(pp_+8*g_), kb_=*(const __attribute__((address_space(3))) i32x4a*)(pp_+8*g_+32); \
        _Pragma("unroll") for(int i_=0;i_<4;++i_){ int da_=qpos-ka_[i_]; da_=da_<0?0:(da_>128?128:da_); int db_=qpos-kb_[i_]; db_=db_<0?0:(db_>128?128:db_); \
          P0[4*g_+i_]+=biasH[da_]; P1[4*g_+i_]+=biasH[db_]; } } } }while(0)
  bool resc=false;
  #define START(P0,P1) do{ const float rm=rowmax(P0,P1); resc=false; \
    { const float dl=rm; mhat=fadd_s(mhat,dl); \
      _Pragma("unroll") for(int r=0;r<16;++r){P0[r]=fsub_s(P0[r],dl);P1[r]=fsub_s(P1[r],dl);} \
      _Pragma("unroll") for(int r=0;r<16;++r)negm[r]=-mhat; asm volatile("":"+v"(negm)); } \
    _Pragma("unroll") for(int r=0;r<16;++r)P0[r]=__builtin_amdgcn_exp2f(P0[r]); }while(0)
  #define RESC() do{ if(resc){ asm volatile("s_waitcnt lgkmcnt(0)":::"memory"); \
      _Pragma("unroll") for(int d_=0;d_<2;++d_) _Pragma("unroll") for(int r=0;r<16;++r)o[d_][r]*=wsf[crow(r,hi)]; } }while(0)
  f32x16 pA0,pA1,pB0,pB1;
  int sl_prev=0,sl_cur=0,sl_next=SLOTB;
  #define ROT() do{sl_prev=sl_cur;sl_cur=sl_next;sl_next=(sl_next==(NSLOT-1)*SLOTB)?0:sl_next+SLOTB;}while(0)
  DMA_K(2,2*SLOTB);
  WAIT_BAR(3);
  qkt(pA0,pA1,Kbase,qr,negm,r32,hi);asm volatile("s_nop 15\n\ts_nop 7":"+v"(pA0),"+v"(pA1));CMASK(pA0,pA1,0);BIAS(pA0,pA1,0);
  START(pA0,pA1);
  _Pragma("unroll") for(int r=0;r<16;++r)pA1[r]=__builtin_amdgcn_exp2f(pA1[r]);
  WAIT_BAR(0);
  DMA_K(3,0);DMA_V(1,SLOTB);
  ROT();
  kload8(kf,kp0+sl_cur);
  WAIT_BAR(2);
  s16x4 vlo[8],vhi[8]; u32x4 pw0,pw1,pw2,pw3;
  #define PKW(P,B) cvtpk_s(P[B],P[B+1])
  #define PAF(k) __builtin_bit_cast(bf16x8,pw##k)
  #define VFR(i) (bf16x8){vlo[i][0],vlo[i][1],vlo[i][2],vlo[i][3],vhi[i][0],vhi[i][1],vhi[i][2],vhi[i][3]}
  #define PIN(x) asm volatile("":"+v"(x))
  #define MX3(a,b,c) __builtin_fmaxf(__builtin_fmaxf((a),(b)),(c))
  #define GAPA(MF,A0,A1,A2,A3,W0,W1,PW) do{ MF; sacc+=A0; sacc+=A1; sacc+=A2; sacc+=A3; PIN(sacc); W0; W1; PIN(PW); SBAR(); }while(0)
  #define EX(v) __builtin_amdgcn_exp2f(v)
  #define GAPB(MF,X,B) do{ MF; X[B]=EX(X[B]); X[B+1]=EX(X[B+1]); X[B+2]=EX(X[B+2]); X[B+3]=EX(X[B+3]); PIN(X); SBAR(); }while(0)
  #define VRD(i) do{ vlo[i]=vtr(vp_+(((i)>>2)*4096+((i)&3)*1024)); vhi[i]=vtr(vp_+(((i)>>2)*4096+((i)&3)*1024+512)); }while(0)
  #define KRD(G,j) do{ if(G){ kload2(kf,kp0+sl_next,j); SBAR(); } }while(0)
  #define STEP(C0,C1,P0,P1,t,GK,GV,GL) do{ SBAR(); \
    const lds_cptr vp_=vp0+sl_prev; \
    VRD(0); SBAR(); float sacc=(P0[0]+P0[1]); \
    GAPA(C0=__builtin_amdgcn_mfma_f32_32x32x16_bf16(kf[0],qr[0],negm,0,0,0), P0[2],P0[3],P0[4],P0[5],     pw0[0]=PKW(P0,0), pw0[1]=PKW(P0,2), pw0); \
    VRD(4); SBAR(); GAPA(C1=__builtin_amdgcn_mfma_f32_32x32x16_bf16(kf[1],qr[0],negm,0,0,0), P0[6],P0[7],P0[8],P0[9],     pw0[2]=PKW(P0,4), pw0[3]=PKW(P0,6), pw0); \
    VRD(1); SBAR(); GAPA(C0=__builtin_amdgcn_mfma_f32_32x32x16_bf16(kf[2],qr[1],C0,0,0,0),   P0[10],P0[11],P0[12],P0[13], pw1[0]=PKW(P0,8), pw1[1]=PKW(P0,10), pw1); \
    VRD(5); SBAR(); GAPA(C1=__builtin_amdgcn_mfma_f32_32x32x16_bf16(kf[3],qr[1],C1,0,0,0),   P0[14],P0[15],P1[0],P1[1],   pw1[2]=PKW(P0,12),pw1[3]=PKW(P0,14), pw1); \
    VRD(2); SBAR(); GAPA(C0=__builtin_amdgcn_mfma_f32_32x32x16_bf16(kf[4],qr[2],C0,0,0,0),   P1[2],P1[3],P1[4],P1[5],     pw2[0]=PKW(P1,0), pw2[1]=PKW(P1,2), pw2); \
    VRD(6); SBAR(); GAPA(C1=__builtin_amdgcn_mfma_f32_32x32x16_bf16(kf[5],qr[2],C1,0,0,0),   P1[6],P1[7],P1[8],P1[9],     pw2[2]=PKW(P1,4), pw2[3]=PKW(P1,6), pw2); \
    VRD(3); SBAR(); GAPA(C0=__builtin_amdgcn_mfma_f32_32x32x16_bf16(kf[6],qr[3],C0,0,0,0),   P1[10],P1[11],P1[12],P1[13], pw3[0]=PKW(P1,8), pw3[1]=PKW(P1,10), pw3); \
    VRD(7); SBAR(); GAPA(C1=__builtin_amdgcn_mfma_f32_32x32x16_bf16(kf[7],qr[3],C1,0,0,0),   P1[14],P1[15],0.f,0.f,       pw3[2]=PKW(P1,12),pw3[3]=PKW(P1,14), pw3); \
    if(MODE==1){ const bool sp_=((selmask>>(((t)-1)>>2))&1u)!=0u; sacc=sp_?sacc:0.f; \
      _Pragma("unroll") for(int i_=0;i_<4;++i_){ pw0[i_]=sp_?pw0[i_]:0u; pw1[i_]=sp_?pw1[i_]:0u; pw2[i_]=sp_?pw2[i_]:0u; pw3[i_]=sp_?pw3[i_]:0u; } } \
    l_reg+=sacc; \
    if(GK){DMA_K((t)+3,sl_cur);} if(GV){DMA_V((t)+1,sl_next);} \
    CMASK(C0,C1,t); BIAS(C0,C1,t); \
    { float a=MX3(C0[0],C0[1],C1[0]),b=MX3(C0[2],C0[3],C1[1]); a=MX3(a,C1[2],C1[3]); \
      _Pragma("unroll") for(int r=4;r<16;r+=4){a=MX3(a,C0[r],C0[r+1]);b=MX3(b,C0[r+2],C0[r+3]);a=MX3(a,C1[r],C1[r+1]);b=MX3(b,C1[r+2],C1[r+3]);} \
      float rm=__builtin_fmaxf(a,b); { auto rr=__builtin_amdgcn_permlane32_swap(__float_as_uint(rm),__float_as_uint(rm),false,false); rm=__builtin_fmaxf(__uint_as_float(rr[0]),__uint_as_float(rr[1])); } \
      resc=false; \
      if(__builtin_expect(__any(rm>(float)THRL),0)){ const float dl=__builtin_fmaxf(rm,0.f); mhat+=dl; \
        _Pragma("unroll") for(int r=0;r<16;++r){C0[r]-=dl;C1[r]-=dl;} \
        _Pragma("unroll") for(int r=0;r<16;++r)negm[r]=-mhat; asm volatile("":"+v"(negm)); \
        const float f=__builtin_amdgcn_exp2f(-dl); l_reg*=f; if(hi==0)wsf[r32]=f; resc=true; } } \
    SBAR(); \
    GAPB(o[0]=__builtin_amdgcn_mfma_f32_32x32x16_bf16(PAF(0),VFR(0),o[0],0,0,0), C0,0); \
    GAPB(o[1]=__builtin_amdgcn_mfma_f32_32x32x16_bf16(PAF(0),VFR(4),o[1],0,0,0), C0,4); \
    KRD(GL,0); GAPB(o[0]=__builtin_amdgcn_mfma_f32_32x32x16_bf16(PAF(1),VFR(1),o[0],0,0,0), C0,8); \
    KRD(GL,1); GAPB(o[1]=__builtin_amdgcn_mfma_f32_32x32x16_bf16(PAF(1),VFR(5),o[1],0,0,0), C0,12); \
    KRD(GL,2); GAPB(o[0]=__builtin_amdgcn_mfma_f32_32x32x16_bf16(PAF(2),VFR(2),o[0],0,0,0), C1,0); \
    KRD(GL,3); GAPB(o[1]=__builtin_amdgcn_mfma_f32_32x32x16_bf16(PAF(2),VFR(6),o[1],0,0,0), C1,4); \
    GAPB(o[0]=__builtin_amdgcn_mfma_f32_32x32x16_bf16(PAF(3),VFR(3),o[0],0,0,0), C1,8); \
    GAPB(o[1]=__builtin_amdgcn_mfma_f32_32x32x16_bf16(PAF(3),VFR(7),o[1],0,0,0), C1,12); \
    }while(0)
  int t=1;
  #undef CMASK
  #define CMASK(P0,P1,t) do{}while(0)
  for(;t+5<NT;t+=2){
    STEP(pB0,pB1,pA0,pA1,t,true,true,true);     WAIT_BAR(2); RESC(); ROT();
    STEP(pA0,pA1,pB0,pB1,t+1,true,true,true);   WAIT_BAR(2); RESC(); ROT();
  }
  #undef CMASK
  #define CMASK(P0,P1,t) do{int jb_=(t)-(NT-4); if(jb_>=0)cmask(P0,P1,jb_,qrel,hi);}while(0)
  #define ENDW(tt) do{ if((tt)+3<NT){WAIT_BAR(2);} else if((tt)+2<NT){WAIT_BAR(1);} else {WAIT_BAR(0);} }while(0)
  for(;t+1<NT;t+=2){
    STEP(pB0,pB1,pA0,pA1,t,(t+3<NT),(t+1<NT),(t+1<NT));       ENDW(t);   RESC(); ROT();
    STEP(pA0,pA1,pB0,pB1,t+1,(t+4<NT),(t+2<NT),(t+2<NT));     ENDW(t+1); RESC(); ROT();
  }
  STEP(pB0,pB1,pA0,pA1,NT-1,false,false,false); RESC();
  { float sacc=pB0[0]+pB0[1]; _Pragma("unroll") for(int r=2;r<16;++r)sacc+=pB0[r]; _Pragma("unroll") for(int r=0;r<16;++r)sacc+=pB1[r]; l_reg+=sacc;
    pw0=(u32x4){PKW(pB0,0),PKW(pB0,2),PKW(pB0,4),PKW(pB0,6)};pw1=(u32x4){PKW(pB0,8),PKW(pB0,10),PKW(pB0,12),PKW(pB0,14)};pw2=(u32x4){PKW(pB1,0),PKW(pB1,2),PKW(pB1,4),PKW(pB1,6)};pw3=(u32x4){PKW(pB1,8),PKW(pB1,10),PKW(pB1,12),PKW(pB1,14)};
    SBAR(); pv(o,vb0+sl_cur,PAF(0),PAF(1),PAF(2),PAF(3)); }
  #undef PKW
  #undef PAF
  #undef VFR
  #undef PIN
  #undef MX3
  #undef GAPA
  #undef GAPB
  #undef EX
  #undef VRD
  #undef KRD
  #undef STEP
  #undef ENDW
  {auto rr=__builtin_amdgcn_permlane32_swap(__float_as_uint(l_reg),__float_as_uint(l_reg),false,false);l_reg=__uint_as_float(rr[0])+__uint_as_float(rr[1]);}
  if(hi==0)wsf[32+r32]=l_reg;asm volatile("s_waitcnt lgkmcnt(0)":::"memory");
  float rli[16];
  #pragma unroll
  for(int r=0;r<16;++r)rli[r]=__builtin_amdgcn_rcpf(wsf[32+crow(r,hi)]);
  bf16*Ow=Oh+(long)(q0+wid*QBLK)*opitch;
  { bf16*stg=(bf16*)(shm+LDS_OST)+wid*2048;
    #pragma unroll
    for(int r=0;r<16;++r){const int orow=crow(r,hi);
      #pragma unroll
      for(int d0=0;d0<2;++d0)stg[orow*64+d0*32+r32]=__float2bfloat16(o[d0][r]*rli[r]);}
    asm volatile("s_waitcnt lgkmcnt(0)":::"memory");
    #pragma unroll
    for(int i=0;i<4;++i){const int row=i*8+(lane>>3),ch=lane&7; const u32x4 v=*(const u32x4*)(stg+row*64+ch*8); ATTN_STORE16(Ow+(long)row*opitch+ch*8,v);} }
  asm volatile("s_waitcnt lgkmcnt(0)\n\ts_barrier":::"memory");
  #undef DMA_K
  #undef DMA_V
  #undef CMASK
  #undef BIAS
  #undef START
  #undef RESC
  #undef ROT
}
constexpr int ATTN_LDS_BYTES=LDS_BYTES;
#undef SBAR
#undef WAIT_BAR
}
struct Ctx { LAS unsigned char* lds; unsigned char* ldsg; int tid, lane, wave, G, bx, gw, ngw, gtid, ngt; };
__device__ __forceinline__ Ctx make_ctx(unsigned char* lds_raw) {
    Ctx X; int t = threadIdx.x; asm volatile("" : "+v"(t));
    X.lds = (LAS unsigned char*)lds_raw; X.ldsg = lds_raw; X.tid = t; X.lane = t & 63; X.wave = __builtin_amdgcn_readfirstlane(t >> 6);
    X.G = gridDim.x; X.bx = blockIdx.x; X.gw = X.bx * 8 + X.wave; X.ngw = X.G * 8; X.gtid = X.bx * 512 + t; X.ngt = X.G * 512; return X; }


__device__ __forceinline__ int map_row(int mode, int n) {
    if (mode == 1) return n < 2560 ? n : (n < 2576 ? 5632 + (n - 2560) : n - 16);
    if (mode == 2) return ((n >> 7) << 8) + (n & 127);
    if (mode == 3) return ((n >> 7) << 8) + 128 + (n & 127);
    return n;
}
constexpr int CVT_SCR = 8448;
struct CvtJob { const float* W; void* WT; int K, N, mode, kb, nb; };
__device__ __forceinline__ void cvt_load(f32x4 (&v)[8], const CvtJob& J, int lane) {
    const int nn = J.nb * 32 + 4 * (lane & 7), kr = lane >> 3; const bool okc = nn < J.N;
#pragma unroll
    for (int i = 0; i < 8; ++i) { const f32x4 x = __builtin_nontemporal_load((const f32x4*)(J.W + (size_t)(J.kb * 64 + 8 * i + kr) * J.N + (okc ? nn : 0))); v[i] = okc ? x : (f32x4){0.f, 0.f, 0.f, 0.f}; }
}
__device__ __forceinline__ void cvt_emit(const f32x4 (&v)[8], const CvtJob& J, bool fp8, LAS float* scr, int lane) {
    const int k0 = J.kb * 64, n0 = J.nb * 32, nq = lane & 7, kr = lane >> 3;
#pragma unroll
    for (int i = 0; i < 8; ++i) { LAS float* d = scr + (8 * i + kr) * 33 + 4 * nq; d[0] = v[i][0]; d[1] = v[i][1]; d[2] = v[i][2]; d[3] = v[i][3]; }
    LDS_WAIT(); asm volatile("" ::: "memory");
    const int c = lane >> 3, nl = lane & 7;
    if (fp8) {
        unsigned char* WT = (unsigned char*)J.WT;
#pragma unroll
        for (int j = 0; j < 4; ++j) { const int n = 8 * j + nl; const LAS float* s = scr + (8 * c) * 33 + n;
            v2u o; o.x = pg8::pk4_fp8(s[0 * 33] * pg8::W8_SCALE, s[1 * 33] * pg8::W8_SCALE, s[2 * 33] * pg8::W8_SCALE, s[3 * 33] * pg8::W8_SCALE);
            o.y = pg8::pk4_fp8(s[4 * 33] * pg8::W8_SCALE, s[5 * 33] * pg8::W8_SCALE, s[6 * 33] * pg8::W8_SCALE, s[7 * 33] * pg8::W8_SCALE);
            if (n0 + n < J.N) *(v2u*)(WT + (size_t)map_row(J.mode, n0 + n) * J.K + k0 + 8 * c) = o; }
    } else {
        bf16* WT = (bf16*)J.WT;
#pragma unroll
        for (int j = 0; j < 4; ++j) { const int n = 8 * j + nl; const LAS float* s = scr + (8 * c) * 33 + n;
            v4u o; o.x = pk2(s[0 * 33], s[1 * 33]); o.y = pk2(s[2 * 33], s[3 * 33]); o.z = pk2(s[4 * 33], s[5 * 33]); o.w = pk2(s[6 * 33], s[7 * 33]);
            if (n0 + n < J.N) *(v4u*)(WT + (size_t)map_row(J.mode, n0 + n) * J.K + k0 + 8 * c) = o; }
    }
    LDS_WAIT(); asm volatile("" ::: "memory");
}
__device__ __forceinline__ void cvt_tile(const float* __restrict__ W, int K, int N, void* __restrict__ WTv, int mode, bool fp8, LAS float* scr, int kb, int nb, int lane) {
    const CvtJob J{W, WTv, K, N, mode, kb, nb}; f32x4 v[8]; cvt_load(v, J, lane); cvt_emit(v, J, fp8, scr, lane);
}
constexpr int DEF_DENSE = 3 * 2816, DEF_TILES = DEF_DENSE + 24 * 3584, DEF_PER_ITEM = 64, DEF_ITEMS = DEF_TILES / DEF_PER_ITEM, DEF_ITEMS_L = DEF_ITEMS / 2;
static_assert(DEF_TILES % DEF_PER_ITEM == 0 && DEF_ITEMS % 2 == 0, "deferred conversion items");
struct DefIn { const float *dw1, *dw3, *dw2, *ew1, *ew3, *ew2; unsigned char* ws; };
__device__ __forceinline__ CvtJob def_job(const DefIn& I, int t) {
    CvtJob J; int nbn, r;
    if (t < DEF_DENSE) { const int j = t / 2816; r = t % 2816;
        if (j == 0) { J.W = I.dw1; J.K = DM; J.N = FFD; J.WT = I.ws + WS_W13; J.mode = 2; nbn = 176; }
        else if (j == 1) { J.W = I.dw3; J.K = DM; J.N = FFD; J.WT = I.ws + WS_W13; J.mode = 3; nbn = 176; }
        else { J.W = I.dw2; J.K = FFD; J.N = DM; J.WT = I.ws + WS_W2; J.mode = 0; nbn = 64; } }
    else { t -= DEF_DENSE; const int j = t / 3584; r = t % 3584;
        if (j < 16) { const int e = j >> 1, wh = j & 1; J.W = (wh ? I.ew3 : I.ew1) + (size_t)e * DM * FFE; J.K = DM; J.N = FFE; J.WT = I.ws + WS_W13E + (size_t)e * 2 * FFE * DM; J.mode = 2 + wh; nbn = 224; }
        else { const int e = j - 16; J.W = I.ew2 + (size_t)e * FFE * DM; J.K = FFE; J.N = DM; J.WT = I.ws + WS_W2E + (size_t)e * DM * FFE; J.mode = 0; nbn = 64; } }
    J.kb = r / nbn; J.nb = r % nbn; return J;
}
__device__ __forceinline__ void cvt8_load(f32x4 (&v)[16], const CvtJob& J, int lane) {
    const float* p = J.W + (size_t)(J.kb * 128 + 16 * (lane >> 3)) * J.N + J.nb * 32 + 4 * (lane & 7);
#pragma unroll
    for (int i = 0; i < 16; ++i) v[i] = __builtin_nontemporal_load((const f32x4*)(p + (size_t)i * J.N));
}
__device__ __forceinline__ void cvt8_emit(const f32x4 (&v)[16], const CvtJob& J, int lane) {
    unsigned E[4][4];
#pragma unroll
    for (int b = 0; b < 4; ++b) {
        unsigned D[4];
#pragma unroll
        for (int i = 0; i < 4; ++i) D[i] = pg8::pk4_fp8_w(v[4 * b + i][0], v[4 * b + i][1], v[4 * b + i][2], v[4 * b + i][3]);
        const unsigned t0 = __builtin_amdgcn_perm(D[1], D[0], 0x05010400u), t1 = __builtin_amdgcn_perm(D[1], D[0], 0x07030602u);
        const unsigned t2 = __builtin_amdgcn_perm(D[3], D[2], 0x05010400u), t3 = __builtin_amdgcn_perm(D[3], D[2], 0x07030602u);
        E[b][0] = __builtin_amdgcn_perm(t2, t0, 0x05040100u); E[b][1] = __builtin_amdgcn_perm(t2, t0, 0x07060302u);
        E[b][2] = __builtin_amdgcn_perm(t3, t1, 0x05040100u); E[b][3] = __builtin_amdgcn_perm(t3, t1, 0x07060302u);
    }
    unsigned char* WT = (unsigned char*)J.WT; const int n = J.nb * 32 + 4 * (lane & 7), kk = J.kb * 128 + 16 * (lane >> 3);
#pragma unroll
    for (int jn = 0; jn < 4; ++jn) { v4u o; o.x = E[0][jn]; o.y = E[1][jn]; o.z = E[2][jn]; o.w = E[3][jn]; *(v4u*)(WT + (size_t)map_row(J.mode, n + jn) * J.K + kk) = o; }
}
__device__ __forceinline__ void def_wave_item(const DefIn& I, int t0, LAS float* scr, int lane) {
    (void)scr;
    CvtJob J0 = def_job(I, t0);
#pragma unroll 1
    for (int b = 0; b < 2; ++b) {
        CvtJob J1 = J0; J1.nb = J0.nb + 1;
        f32x4 v0[16], v1[16];
        cvt8_load(v0, J0, lane); cvt8_load(v1, J1, lane);
        cvt8_emit(v0, J0, lane); cvt8_emit(v1, J1, lane);
        J0.nb += 2;
    }
}
struct P0In { const float *c, *w_ada, *w_in, *w_out, *dw1, *dw3, *dw2, *ew1, *ew3, *ew2; unsigned char* ws; };
__device__ __forceinline__ void mod_item(const Ctx& X, const float* __restrict__ w_ada, float* __restrict__ modp, int l, int r) {
    const LAS float* cact = (const LAS float*)(X.lds); LAS f32x4* red = (LAS f32x4*)(X.lds + 8192);
    const int cg = r >> 2, ks = r & 3;
    const float* Wb = w_ada + (size_t)l * DM * NMOD + (size_t)(ks * 512 + X.wave * 64) * NMOD + cg * 256 + 4 * X.lane;
    f32x4 acc = {0.f, 0.f, 0.f, 0.f};
#pragma unroll 1
    for (int i0 = 0; i0 < 64; i0 += 16) { f32x4 w[16];
#pragma unroll
        for (int i = 0; i < 16; ++i) w[i] = __builtin_nontemporal_load((const f32x4*)(Wb + (size_t)(i0 + i) * NMOD));
        asm volatile("" ::: "memory");
#pragma unroll
        for (int i = 0; i < 16; ++i) acc += w[i] * cact[ks * 512 + X.wave * 64 + i0 + i]; }
    red[X.wave * 64 + X.lane] = acc;
    __syncthreads();
    if (X.tid < 256) { float s = 0.f;
#pragma unroll
        for (int w = 0; w < 8; ++w) s += ((LAS float*)red)[(w * 64 + (X.tid >> 2)) * 4 + (X.tid & 3)];
        modp[(size_t)(ks * 2 + l) * NMOD + cg * 256 + X.tid] = s; }
    __syncthreads();
}
constexpr int P0_IA = 32 * 177, P0_IB = 32 * 64;
__device__ __forceinline__ CvtJob inout_job(const P0In& I, int l, int t, bool& fp8) {
    CvtJob J;
    if (t < P0_IA) { J.W = I.w_in + (size_t)l * DM * NIN; J.K = DM; J.N = NIN; J.WT = I.ws + WS_WIN + (size_t)l * NPROJ_T * DM; J.mode = 1; J.kb = t / 177; J.nb = t % 177; fp8 = true; }
    else { t -= P0_IA; J.W = I.w_out + (size_t)l * DM * DM; J.K = DM; J.N = DM; J.mode = 0; J.kb = t / 64; J.nb = t % 64;
#if OUTPROJ_FP8
        J.WT = I.ws + WS_WOUT + (size_t)l * DM * DM; fp8 = true;
#else
        J.WT = (bf16*)(I.ws + WS_WOUT) + (size_t)l * DM * DM; fp8 = false;
#endif
    }
    return J;
}
__device__ __forceinline__ void inout_run(const P0In& I, int l, int t0, int step, int tend, LAS float* scr, int lane) {
    const int last = tend - 1; bool fa = false, fb = false; f32x4 va[8], vb[8];
    CvtJob Ja = inout_job(I, l, t0 < tend ? t0 : last, fa), Jb; cvt_load(va, Ja, lane);
    for (int t = t0; t < tend; t += 2 * step) { const int t1 = t + step, t2 = t + 2 * step;
        Jb = inout_job(I, l, t1 < tend ? t1 : last, fb); cvt_load(vb, Jb, lane);
        cvt_emit(va, Ja, fa, scr, lane);
        Ja = inout_job(I, l, t2 < tend ? t2 : last, fa); cvt_load(va, Ja, lane);
        if (t1 < tend) cvt_emit(vb, Jb, fb, scr, lane); }
}
__device__ __forceinline__ void inout_tile(const P0In& I, int l, int t, LAS float* scr, int lane) {
    if (t < P0_IA) cvt_tile(I.w_in + (size_t)l * DM * NIN, DM, NIN, I.ws + WS_WIN + (size_t)l * NPROJ_T * DM, 1, true, scr, t / 177, t % 177, lane);
#if OUTPROJ_FP8
    else if (t < P0_IA + P0_IB) { t -= P0_IA; cvt_tile(I.w_out + (size_t)l * DM * DM, DM, DM, I.ws + WS_WOUT + (size_t)l * DM * DM, 0, true, scr, t / 64, t % 64, lane); }
#else
    else if (t < P0_IA + P0_IB) { t -= P0_IA; cvt_tile(I.w_out + (size_t)l * DM * DM, DM, DM, (bf16*)(I.ws + WS_WOUT) + (size_t)l * DM * DM, 0, false, scr, t / 64, t % 64, lane); }
#endif
}
__device__ __forceinline__ void p0_prologue(const Ctx& X, const P0In& I) {
    LAS float* cact = (LAS float*)(X.lds);
    for (int k = X.tid; k < DM; k += 512) cact[k] = siluf(I.c[k]);
    __syncthreads();
    for (int bi = X.bx; bi < 192; bi += X.G) mod_item(X, I.w_ada, (float*)(I.ws + WS_MODP), 0, bi);
    { const v4u z = {0u, 0u, 0u, 0u};
      for (int i = X.gtid; i < 2 * 30720; i += X.ngt) { const int l = i / 30720, r = i % 30720;
          *(v4u*)(I.ws + WS_WIN + (size_t)l * NPROJ_T * DM + (size_t)NIN * DM + (size_t)r * 16) = z; } }
    __syncthreads();
    LAS float* scr = (LAS float*)(X.lds + X.wave * CVT_SCR);
    inout_run(I, 0, X.gw, X.ngw, P0_IA + P0_IB, scr, X.lane);
}
constexpr int EXTRA_MOD = 192, EXTRA_TILE_ITEMS = (P0_IA + P0_IB + 63) / 64, EXTRA_ITEMS = EXTRA_MOD + EXTRA_TILE_ITEMS;

template <bool ROUTER, bool OUT8, bool IN16>
__device__ __forceinline__ void rms_rows(const Ctx& X, const void* __restrict__ Xin, void* __restrict__ Hv, const LAS float* sh, const LAS float* gs,
                                         const LAS float* router_w_lds, unsigned* cnt, unsigned* route) {
    f32x4 nv[8]; v2u nr[8];
    if (X.gw < NTOK) {
        if (IN16) { const v2u* xr = (const v2u*)((const bf16*)Xin + (size_t)X.gw * DM) + X.lane;
#pragma unroll
            for (int j = 0; j < 8; ++j) nr[j] = xr[64 * j]; }
        else { const f32x4* xr = (const f32x4*)((const float*)Xin + (size_t)X.gw * DM) + X.lane;
#pragma unroll
            for (int j = 0; j < 8; ++j) nv[j] = xr[64 * j]; } }
    for (int t = X.gw; t < NTOK; t += X.ngw) {
        f32x4 v[8]; float s = 0.f;
#pragma unroll
        for (int j = 0; j < 8; ++j) { if (IN16) v[j] = (f32x4){bflo(nr[j].x), bfhi(nr[j].x), bflo(nr[j].y), bfhi(nr[j].y)}; else v[j] = nv[j]; }
        if (t + X.ngw < NTOK) {
            if (IN16) { const v2u* xr = (const v2u*)((const bf16*)Xin + (size_t)(t + X.ngw) * DM) + X.lane;
#pragma unroll
                for (int j = 0; j < 8; ++j) nr[j] = xr[64 * j]; }
            else { const f32x4* xr = (const f32x4*)((const float*)Xin + (size_t)(t + X.ngw) * DM) + X.lane;
#pragma unroll
                for (int j = 0; j < 8; ++j) nv[j] = xr[64 * j]; } }
        asm volatile("" ::: "memory");
#pragma unroll
        for (int j = 0; j < 8; ++j) s += (v[j][0] * v[j][0] + v[j][1] * v[j][1]) + (v[j][2] * v[j][2] + v[j][3] * v[j][3]);
        s = wave_sum(s);
        const float r = 1.0f / sqrtf(s * (1.0f / DM) + EPSF);
        float lg[8]; unsigned hq[8];
        if (ROUTER) {
#pragma unroll
            for (int e = 0; e < 8; ++e) lg[e] = 0.f; }
#pragma unroll
        for (int j = 0; j < 8; ++j) { const int c = 4 * X.lane + 256 * j;
            const f32x4 g4 = *(const LAS f32x4*)(gs + c), s4 = *(const LAS f32x4*)(sh + c);
            const f32x4 h = v[j] * r * g4 + s4;
            if (OUT8) { const unsigned q_ = pg8::pk4_fp8(h[0] * pg8::A8_SCALE, h[1] * pg8::A8_SCALE, h[2] * pg8::A8_SCALE, h[3] * pg8::A8_SCALE); if (ROUTER) hq[j] = q_; else *(unsigned*)((unsigned char*)Hv + (size_t)t * DM + c) = q_; }
            else { v2u o; o.x = pk2(h[0], h[1]); o.y = pk2(h[2], h[3]); *(v2u*)((bf16*)Hv + (size_t)t * DM + c) = o; }
            if (ROUTER) {
#pragma unroll
                for (int e = 0; e < 8; ++e) { const f32x4 w = *(const LAS f32x4*)((const LAS float*)router_w_lds + e * DM + c);
                    lg[e] += (h[0] * w[0] + h[1] * w[1]) + (h[2] * w[2] + h[3] * w[3]); } }
        }
        if (ROUTER) {
#pragma unroll
            for (int e = 0; e < 8; ++e) lg[e] = wave_sum(lg[e]);
            int e0 = 0; float m0 = lg[0];
#pragma unroll
            for (int e = 1; e < 8; ++e) if (lg[e] > m0) { m0 = lg[e]; e0 = e; }
            int e1 = -1; float m1 = -INFINITY;
#pragma unroll
            for (int e = 0; e < 8; ++e) if (e != e0 && lg[e] > m1) { m1 = lg[e]; e1 = e; }
            const float w0 = 1.0f / (1.0f + __expf(m1 - m0)), w1 = 1.0f - w0;
            unsigned p0 = 0u, p1 = 0u;
            if (X.lane == 0) {
                p0 = __hip_atomic_fetch_add(cnt + e0, 1u, RLX_AGENT); p1 = __hip_atomic_fetch_add(cnt + e1, 1u, RLX_AGENT);
                unsigned* rt = route + (size_t)t * 8;
                rt[0] = (unsigned)e0; rt[1] = (unsigned)e1; rt[2] = p0; rt[3] = p1; rt[4] = __float_as_uint(w0); rt[5] = __float_as_uint(w1); }
            p0 = (unsigned)__builtin_amdgcn_readfirstlane((int)p0); p1 = (unsigned)__builtin_amdgcn_readfirstlane((int)p1);
            unsigned char* d0 = (unsigned char*)Hv + ((size_t)e0 * NTOK + p0) * DM + 4 * X.lane; unsigned char* d1 = (unsigned char*)Hv + ((size_t)e1 * NTOK + p1) * DM + 4 * X.lane;
#pragma unroll
            for (int j = 0; j < 8; ++j) { *(unsigned*)(d0 + 256 * j) = hq[j]; *(unsigned*)(d1 + 256 * j) = hq[j]; }
        }
    }
}

struct P3In { const bf16* proj; const float* dtraw; const float *conv_w, *conv_b, *dt_bias, *a_log; bf16* xc; float *dtv, *acs, *km; };
__device__ __forceinline__ void p3_conv(const Ctx& X, const P3In& I) {
    LAS float* cwL = (LAS float*)(X.lds);
    __syncthreads();
    for (int i = X.tid; i < 4 * 1536; i += 512) cwL[i] = I.conv_w[i];
    for (int i = X.tid; i < 1536; i += 512) cwL[4 * 1536 + i] = I.conv_b[i];
    __syncthreads();
#define CONV_LOAD(dst, idx_) do { const int t_ = (idx_) / 192, ch_ = ((idx_) % 192) * 8; \
        _Pragma("unroll") for (int j = 0; j < 4; ++j) { const int tt_ = t_ - 3 + j; dst[j] = *(const v4u*)(I.proj + (size_t)(tt_ < 0 ? 0 : tt_) * NPROJ + C_XBC + ch_); } } while (0)
#define CONV_ITEM(src, idx_) do { const int t = (idx_) / 192, ch = ((idx_) % 192) * 8; float a[8]; \
        { const f32x4 b0 = *(const LAS f32x4*)(cwL + 4 * 1536 + ch), b1 = *(const LAS f32x4*)(cwL + 4 * 1536 + ch + 4); a[0] = b0[0]; a[1] = b0[1]; a[2] = b0[2]; a[3] = b0[3]; a[4] = b1[0]; a[5] = b1[1]; a[6] = b1[2]; a[7] = b1[3]; } \
        _Pragma("unroll") for (int j = 0; j < 4; ++j) { v4u raw = src[j]; if (t - 3 + j < 0) raw = (v4u){0u, 0u, 0u, 0u}; \
            const f32x4 w0 = *(const LAS f32x4*)(cwL + j * 1536 + ch), w1 = *(const LAS f32x4*)(cwL + j * 1536 + ch + 4); \
            a[0] += w0[0] * bflo(raw.x); a[1] += w0[1] * bfhi(raw.x); a[2] += w0[2] * bflo(raw.y); a[3] += w0[3] * bfhi(raw.y); \
            a[4] += w1[0] * bflo(raw.z); a[5] += w1[1] * bfhi(raw.z); a[6] += w1[2] * bflo(raw.w); a[7] += w1[3] * bfhi(raw.w); } \
        v4u o; o.x = pk2(siluf(a[0]), siluf(a[1])); o.y = pk2(siluf(a[2]), siluf(a[3])); o.z = pk2(siluf(a[4]), siluf(a[5])); o.w = pk2(siluf(a[6]), siluf(a[7])); \
        *(v4u*)(I.xc + (size_t)t * 1536 + ch) = o; } while (0)
    { constexpr int NIT = NTOK * 192; v4u ra[4], rb[4];
      CONV_LOAD(ra, (X.gtid < NIT ? X.gtid : NIT - 1));
      for (int idx = X.gtid; idx < NIT; idx += 2 * X.ngt) {
          const int i1 = idx + X.ngt, i2 = idx + 2 * X.ngt;
          CONV_LOAD(rb, (i1 < NIT ? i1 : NIT - 1));
          CONV_ITEM(ra, idx);
          CONV_LOAD(ra, (i2 < NIT ? i2 : NIT - 1));
          if (i1 < NIT) CONV_ITEM(rb, i1); } }
#undef CONV_LOAD
#undef CONV_ITEM
    for (int wi = X.gw; wi < 512; wi += X.ngw) {
        const int c = wi >> 4, h = wi & 15; const float a = -__expf(I.a_log[h]), db = I.dt_bias[h];
        float dv[4], cs[4]; float run = 0.f;
        float xr_[4];
#pragma unroll
        for (int i = 0; i < 4; ++i) xr_[i] = I.dtraw[(size_t)(c * 256 + 4 * X.lane + i) * 16 + h];
        asm volatile("" ::: "memory");
#pragma unroll
        for (int i = 0; i < 4; ++i) { const float x = xr_[i] + db;
            dv[i] = x > 20.f ? x : log1pf(__expf(x)); run += dv[i] * a; cs[i] = run; }
        float tot = run;
#pragma unroll
        for (int o = 1; o < 64; o <<= 1) { const float n = __shfl_up(tot, o); if (X.lane >= o) tot += n; }
        const float ex = tot - run;
#pragma unroll
        for (int i = 0; i < 4; ++i) { const int t = c * 256 + 4 * X.lane + i; I.dtv[(size_t)t * 16 + h] = dv[i]; I.acs[(size_t)t * 16 + h] = ex + cs[i]; }
    }
    for (int wi = X.gw; wi < 2048; wi += X.ngw) {
        const int j = wi >> 6, hd = (wi >> 3) & 7, rs = wi & 7;
        const bf16* p = I.proj + (size_t)(j * 256 + rs * 32) * NPROJ + C_MK + hd * 64 + X.lane; float s = 0.f;
        bf16 rw[32];
#pragma unroll
        for (int r = 0; r < 32; ++r) rw[r] = p[(size_t)r * NPROJ];
        asm volatile("" ::: "memory");
#pragma unroll
        for (int r = 0; r < 32; ++r) s += bf1(rw[r]);
        I.km[(size_t)rs * 16384 + ((size_t)hd * 32 + j) * 64 + X.lane] = s;
    }
}

typedef short bf16x8 __attribute__((ext_vector_type(8)));
typedef float f32x16 __attribute__((ext_vector_type(16)));
__device__ __forceinline__ int crow(int r, int hi) { return (r & 3) + 8 * (r >> 2) + 4 * hi; }
constexpr int SSD_PITCH = 264;
constexpr int SSD_XT = 0, SSD_BT = 33792, SSD_MS = SSD_BT + 67584, SSD_AC = SSD_MS + 8 * 2560, SSD_LDS = SSD_AC + 2048;
static_assert(SSD_LDS <= LDSCTL_OFF, "SSD LDS map");
__device__ __forceinline__ void ssd_a_unit(const Ctx& X, const bf16* __restrict__ xc, const float* __restrict__ dtv, const float* __restrict__ acs, float* __restrict__ yraw, float* __restrict__ sst, int c, int h) {
    const int g = h >> 3, r = X.lane & 31, hh = X.lane >> 5, w = X.wave;
    LAS bf16* XT = (LAS bf16*)(X.lds + SSD_XT); LAS bf16* BT = (LAS bf16*)(X.lds + SSD_BT); LAS bf16* MS = (LAS bf16*)(X.lds + SSD_MS + w * 2560);
    LAS float* AC = (LAS float*)(X.lds + SSD_AC); LAS float* DV = AC + 256;
    const int l0 = 32 * w;
    const int s_ = X.tid >> 1, ph = X.tid & 1;
    v4u xs[4], bs[8]; float a_in = 0.f, d_in = 0.f;
    { const bf16* src = xc + (size_t)(c * 256 + s_) * 1536 + h * 64 + ph * 32;
#pragma unroll
      for (int i = 0; i < 4; ++i) xs[i] = *(const v4u*)(src + 8 * i); }
    if (X.tid < 256) { a_in = acs[(size_t)(c * 256 + X.tid) * 16 + h]; d_in = dtv[(size_t)(c * 256 + X.tid) * 16 + h]; }
    { const bf16* src = xc + (size_t)(c * 256 + s_) * 1536 + 1024 + g * 128 + ph * 64;
#pragma unroll
      for (int i = 0; i < 8; ++i) bs[i] = *(const v4u*)(src + 8 * i); }
    bf16x8 cf[8], bn[8];
    { const bf16* cp = xc + (size_t)(c * 256 + l0 + r) * 1536 + 1280 + g * 128 + 8 * hh; const bf16* bp = xc + (size_t)(c * 256 + r) * 1536 + 1024 + g * 128 + 8 * hh;
#pragma unroll
      for (int ks = 0; ks < 8; ++ks) { cf[ks] = *(const bf16x8*)(cp + 16 * ks); bn[ks] = *(const bf16x8*)(bp + 16 * ks); } }
    __syncthreads();
#pragma unroll
    for (int i = 0; i < 4; ++i) { const v4u v = xs[i]; LAS bf16* d = XT + (ph * 32 + 8 * i) * SSD_PITCH + s_;
        d[0 * SSD_PITCH] = (bf16)(v.x & 0xffffu); d[1 * SSD_PITCH] = (bf16)(v.x >> 16); d[2 * SSD_PITCH] = (bf16)(v.y & 0xffffu); d[3 * SSD_PITCH] = (bf16)(v.y >> 16);
        d[4 * SSD_PITCH] = (bf16)(v.z & 0xffffu); d[5 * SSD_PITCH] = (bf16)(v.z >> 16); d[6 * SSD_PITCH] = (bf16)(v.w & 0xffffu); d[7 * SSD_PITCH] = (bf16)(v.w >> 16); }
    if (X.tid < 256) { AC[X.tid] = a_in; DV[X.tid] = d_in; }
    __syncthreads();
    { const float wl = __expf(AC[255] - AC[s_]) * DV[s_];
#pragma unroll
      for (int i = 0; i < 8; ++i) { const v4u v = bs[i]; LAS bf16* d = BT + (ph * 64 + 8 * i) * SSD_PITCH + s_;
          d[0 * SSD_PITCH] = (bf16)f2bf(bflo(v.x) * wl); d[1 * SSD_PITCH] = (bf16)f2bf(bfhi(v.x) * wl); d[2 * SSD_PITCH] = (bf16)f2bf(bflo(v.y) * wl); d[3 * SSD_PITCH] = (bf16)f2bf(bfhi(v.y) * wl);
          d[4 * SSD_PITCH] = (bf16)f2bf(bflo(v.z) * wl); d[5 * SSD_PITCH] = (bf16)f2bf(bfhi(v.z) * wl); d[6 * SSD_PITCH] = (bf16)f2bf(bflo(v.w) * wl); d[7 * SSD_PITCH] = (bf16)f2bf(bfhi(v.w) * wl); } }
    float al[16];
#pragma unroll
    for (int q = 0; q < 16; ++q) al[q] = AC[l0 + crow(q, hh)];
    f32x16 y0 = {}, y1 = {};
    for (int j = 0; j <= w; ++j) {
        bf16x8 bc[8];
#pragma unroll
        for (int ks = 0; ks < 8; ++ks) bc[ks] = bn[ks];
        if (j < w) { const bf16* bp = xc + (size_t)(c * 256 + 32 * (j + 1) + r) * 1536 + 1024 + g * 128 + 8 * hh;
#pragma unroll
            for (int ks = 0; ks < 8; ++ks) bn[ks] = *(const bf16x8*)(bp + 16 * ks); }
        f32x16 acc = {};
#pragma unroll
        for (int ks = 0; ks < 8; ++ks) acc = __builtin_amdgcn_mfma_f32_32x32x16_bf16(cf[ks], bc[ks], acc, 0, 0, 0);
        const int s = 32 * j + r; const float as = AC[s], ds = DV[s];
#pragma unroll
        for (int q = 0; q < 16; ++q) { const int l = l0 + crow(q, hh); const float e = (s <= l) ? __expf(al[q] - as) : 0.f;
            MS[crow(q, hh) * 40 + r] = (bf16)f2bf(acc[q] * e * ds); }
        LDS_WAIT(); asm volatile("" ::: "memory");
#pragma unroll
        for (int k2 = 0; k2 < 2; ++k2) { const bf16x8 a = *(const LAS bf16x8*)(MS + r * 40 + 16 * k2 + 8 * hh);
            const bf16x8 b0 = *(const LAS bf16x8*)(XT + r * SSD_PITCH + 32 * j + 16 * k2 + 8 * hh), b1 = *(const LAS bf16x8*)(XT + (32 + r) * SSD_PITCH + 32 * j + 16 * k2 + 8 * hh);
            y0 = __builtin_amdgcn_mfma_f32_32x32x16_bf16(a, b0, y0, 0, 0, 0); y1 = __builtin_amdgcn_mfma_f32_32x32x16_bf16(a, b1, y1, 0, 0, 0); }
        LDS_WAIT(); asm volatile("" ::: "memory");
    }
#pragma unroll
    for (int q = 0; q < 16; ++q) { float* yp = yraw + (size_t)(c * 256 + l0 + crow(q, hh)) * 1024 + h * 64; yp[r] = y0[q]; yp[32 + r] = y1[q]; }
    __syncthreads();
    { const int pb = w & 1, nb = w >> 1; f32x16 sa = {};
#pragma unroll
      for (int ks = 0; ks < 16; ++ks) { const bf16x8 a = *(const LAS bf16x8*)(XT + (32 * pb + r) * SSD_PITCH + 16 * ks + 8 * hh), b = *(const LAS bf16x8*)(BT + (32 * nb + r) * SSD_PITCH + 16 * ks + 8 * hh);
          sa = __builtin_amdgcn_mfma_f32_32x32x16_bf16(a, b, sa, 0, 0, 0); }
#pragma unroll
      for (int q = 0; q < 16; ++q) sst[(((size_t)c * 16 + h) * 64 + 32 * pb + crow(q, hh)) * 128 + 32 * nb + r] = sa[q]; }
}
__device__ __forceinline__ void ssd_scan(const Ctx& X, const float* __restrict__ sst, const float* __restrict__ acs, bf16* __restrict__ hp) {
    for (int e = X.gtid; e < 131072; e += X.ngt) { const int h = e >> 13; float hv = 0.f;
        float sv[32], dv[32];
#pragma unroll
        for (int c = 0; c < 32; ++c) { sv[c] = sst[(size_t)c * 131072 + e]; dv[c] = acs[(size_t)(c * 256 + 255) * 16 + h]; }
#pragma unroll
        for (int c = 0; c < 32; ++c) { hp[(size_t)c * 131072 + e] = (bf16)f2bf(hv); hv = __expf(dv[c]) * hv + sv[c]; } }
}
__device__ __forceinline__ void ssd_c_unit(const Ctx& X, const bf16* __restrict__ xc, const float* __restrict__ acs, const bf16* __restrict__ hp, float* __restrict__ yraw, int c, int h) {
    const int g = h >> 3, r = X.lane & 31, hh = X.lane >> 5, l0 = 32 * X.wave;
    bf16x8 cf[8], hb0[8], hb1[8];
    float yv0[16], yv1[16], av[16];
    { const bf16* cp = xc + (size_t)(c * 256 + l0 + r) * 1536 + 1280 + g * 128 + 8 * hh;
      const bf16* h0 = hp + (((size_t)c * 16 + h) * 64 + r) * 128 + 8 * hh; const bf16* h1 = h0 + 32 * 128;
#pragma unroll
      for (int ks = 0; ks < 8; ++ks) { cf[ks] = *(const bf16x8*)(cp + 16 * ks); hb0[ks] = *(const bf16x8*)(h0 + 16 * ks); hb1[ks] = *(const bf16x8*)(h1 + 16 * ks); } }
#pragma unroll
    for (int q = 0; q < 16; ++q) { const int t = c * 256 + l0 + crow(q, hh); const float* yp = yraw + (size_t)t * 1024 + h * 64 + r; av[q] = acs[(size_t)t * 16 + h]; yv0[q] = yp[0]; yv1[q] = yp[32]; }
    f32x16 a0 = {}, a1 = {};
#pragma unroll
    for (int ks = 0; ks < 8; ++ks) { a0 = __builtin_amdgcn_mfma_f32_32x32x16_bf16(cf[ks], hb0[ks], a0, 0, 0, 0); a1 = __builtin_amdgcn_mfma_f32_32x32x16_bf16(cf[ks], hb1[ks], a1, 0, 0, 0); }
#pragma unroll
    for (int q = 0; q < 16; ++q) { const int t = c * 256 + l0 + crow(q, hh); float* yp = yraw + (size_t)t * 1024 + h * 64 + r; const float e = __expf(av[q]); yp[0] = yv0[q] + e * a0[q]; yp[32] = yv1[q] + e * a1[q]; }
}
__device__ __forceinline__ void build_bias_table(const Ctx& X, const float* __restrict__ rel_bias, LAS float* biasT) {
    float bn[4], bf_[4];
#pragma unroll
    for (int q = 0; q < 4; ++q) { const int idx0 = X.tid + 512 * q, idx = idx0 < 12 * 129 ? idx0 : 12 * 129 - 1; const int hh = idx / 129, d = idx % 129;
        int b; if (d < 16) b = d; else { b = 16 + (int)(logf((float)d / 16.0f) / 2.0794415416798357f * 16.0f); if (b > 31) b = 31; }
        bn[q] = rel_bias[b * 12 + hh]; bf_[q] = rel_bias[31 * 12 + hh]; }
    asm volatile("" ::: "memory");
#pragma unroll
    for (int q = 0; q < 4; ++q) { const int idx = X.tid + 512 * q; if (idx < 12 * 129) biasT[(idx / 129) * 132 + idx % 129] = (bn[q] - bf_[q]) * LOG2E; }
}

constexpr int ATT_POS = 86016, ATT_KMAX = ATT_POS + 32768, ATT_BIAS = ATT_KMAX + 512, ATT_KM = ATT_BIAS + 6400, ATT_END = ATT_KM + 8192;
static_assert(attn_body::ATTN_LDS_BYTES <= ATT_POS && ATT_END <= LDSCTL_OFF, "attention LDS map");
__device__ __forceinline__ void attn_phase(const Ctx& X, const bf16* __restrict__ proj, const float* __restrict__ km, const int* __restrict__ positions, const float* __restrict__ rel_bias,
                                           bf16* moba, bf16* diff, unsigned* qctr, volatile LAS unsigned* qslot, const DefIn& DI, const int def_base, const P0In& PI, const int extra) {
    LAS int* posL = (LAS int*)(X.lds + ATT_POS); LAS int* kmaxL = (LAS int*)(X.lds + ATT_KMAX); LAS float* biasT = (LAS float*)(X.lds + ATT_BIAS); LAS float* kmL = (LAS float*)(X.lds + ATT_KM);
    __syncthreads();
    { int pv[NTOK / 512];
#pragma unroll
      for (int q = 0; q < NTOK / 512; ++q) pv[q] = positions[X.tid + 512 * q];
      asm volatile("" ::: "memory");
#pragma unroll
      for (int q = 0; q < NTOK / 512; ++q) posL[X.tid + 512 * q] = pv[q]; }
    build_bias_table(X, rel_bias, biasT);
    __syncthreads();
    if (X.tid < 128) { int m = posL[64 * X.tid]; for (int k = 1; k < 64; ++k) { const int v = posL[64 * X.tid + k]; m = v > m ? v : m; } kmaxL[X.tid] = m; }
    __syncthreads();
    typedef attn_body::bf16 abf;
    int it = 0;
#define DRAIN_CONV() for (;; ++it) { if (X.tid == 0) qslot[it & 1] = __hip_atomic_fetch_add(qctr + 32, 1u, RLX_AGENT); __syncthreads(); \
        int ci = __builtin_amdgcn_readfirstlane((int)qslot[it & 1]); if (ci >= DEF_ITEMS_L + extra) { ++it; break; } \
        int ln = X.lane; asm volatile("" : "+v"(ln)); \
        if (ci < extra) { \
            if (ci < EXTRA_MOD) { int tl = X.tid; asm volatile("" : "+v"(tl)); LAS float* cact = (LAS float*)(X.lds); for (int k = tl; k < DM; k += 512) cact[k] = siluf(PI.c[k]); __syncthreads(); \
                mod_item(X, PI.w_ada, (float*)(PI.ws + WS_MODP), 1, ci); } \
            else { const int tb = (ci - EXTRA_MOD) * 64 + X.wave * 8, te = tb + 8 < P0_IA + P0_IB ? tb + 8 : P0_IA + P0_IB; if (tb < te) inout_run(PI, 1, tb, 1, te, (LAS float*)(X.lds + X.wave * CVT_SCR), ln); } \
            continue; } \
        ci -= extra; \
        { const int tt_ = (def_base + ci) * DEF_PER_ITEM + X.wave * (DEF_PER_ITEM / 8);        \
          def_wave_item(DI, tt_, (LAS float*)(X.lds + X.wave * CVT_SCR), ln); def_wave_item(DI, tt_ + 4, (LAS float*)(X.lds + X.wave * CVT_SCR), ln); } }
    if (((X.bx >> 3) & 7) < 3) { DRAIN_CONV(); }
    const unsigned myx = xb_xcc_id() & 7u;
    for (unsigned xo = 0; xo < 8u; ++xo) {
    const unsigned xq = (myx + xo) & 7u;
    for (;; ++it) {
        if (X.tid == 0) qslot[it & 1] = __hip_atomic_fetch_add(qctr + 64 + 64 * xq, 1u, RLX_AGENT);
        __syncthreads();
        const unsigned u = (unsigned)__builtin_amdgcn_readfirstlane((int)qslot[it & 1]);
        if (u >= 96u) { ++it; break; }
        const int qb = 31 - (int)(u / 3u), wh = (int)(u % 3u), sub = wh == 0 ? (int)xq : 8 + 2 * (int)xq + (wh - 1);
        if (sub < 8) {
            int tl = X.tid; asm volatile("" : "+v"(tl));
            { float kv[4][8];
#pragma unroll
              for (int q = 0; q < 4; ++q)
#pragma unroll
                  for (int rs = 0; rs < 8; ++rs) kv[q][rs] = km[(size_t)rs * 16384 + sub * 2048 + tl + 512 * q];
              asm volatile("" ::: "memory");
#pragma unroll
              for (int q = 0; q < 4; ++q) { float s = 0.f;
#pragma unroll
                  for (int rs = 0; rs < 8; ++rs) s += kv[q][rs];
                  kmL[tl + 512 * q] = s * (1.0f / 256.0f); } }
            __syncthreads();
            attn_body::attn_unit<8, 1>(qb, (const abf*)(proj + C_MQ + sub * 64), (const abf*)(proj + C_MK + sub * 64), (const abf*)(proj + C_MV + sub * 64), (abf*)(moba + sub * 64), 512,
                                       (char*)X.ldsg, posL, kmaxL, biasT + sub * 132, kmL);
        } else {
            const int v = sub - 8, h = v >> 2, m = (v >> 1) & 1, half = v & 1;
            attn_body::attn_unit<8, 0>(qb, (const abf*)(proj + C_DQ + h * 128 + m * 64), (const abf*)(proj + C_DK + h * 128 + m * 64), (const abf*)(proj + C_DV + h * 128 + half * 64),
                                       (abf*)(diff + (h * 2 + m) * 128 + half * 64), 1024, (char*)X.ldsg, posL, kmaxL, biasT + (8 + h) * 132, kmL);
        }
    }
    }
    DRAIN_CONV();
#undef DRAIN_CONV
}

__device__ __forceinline__ void bias_gemv8(const Ctx& X, const unsigned char* __restrict__ W8, const float* __restrict__ sh, float* __restrict__ bias, int nrows) {
    float s[32];
#pragma unroll
    for (int i = 0; i < 8; ++i) { const f32x4 v = *(const f32x4*)(sh + 32 * X.lane + 4 * i); s[4 * i] = v[0]; s[4 * i + 1] = v[1]; s[4 * i + 2] = v[2]; s[4 * i + 3] = v[3]; }
    typedef float f32x2 __attribute__((ext_vector_type(2)));
    for (int n0 = X.gw; n0 < nrows; n0 += 6 * X.ngw) {
        v4u ra[6], rb[6];
#pragma unroll
        for (int q = 0; q < 6; ++q) { const int n1 = n0 + q * X.ngw, n = n1 < nrows ? n1 : nrows - 1; ra[q] = *(const v4u*)(W8 + (size_t)n * DM + 32 * X.lane); rb[q] = *(const v4u*)(W8 + (size_t)n * DM + 32 * X.lane + 16); }
        asm volatile("" ::: "memory");
#pragma unroll
        for (int q = 0; q < 6; ++q) { const int n = n0 + q * X.ngw;
            const unsigned w[8] = {ra[q].x, ra[q].y, ra[q].z, ra[q].w, rb[q].x, rb[q].y, rb[q].z, rb[q].w}; float acc = 0.f;
#pragma unroll
            for (int i = 0; i < 8; ++i) { const f32x2 lo = __builtin_amdgcn_cvt_pk_f32_fp8((int)w[i], false), hi = __builtin_amdgcn_cvt_pk_f32_fp8((int)w[i], true);
                acc += s[4 * i] * lo[0] + s[4 * i + 1] * lo[1] + s[4 * i + 2] * hi[0] + s[4 * i + 3] * hi[1]; }
            acc = wave_sum(acc);
            if (n < nrows && X.lane == 0) bias[n] = acc * (1.0f / pg8::W8_SCALE); }
    }
}

struct P5In { const float* yraw; const bf16 *xc, *proj, *moba, *diff; const float *d_skip, *ssd_g, *moba_g, *lamp, *subln_g; float lambda_init; unsigned char* y; };
struct P5Row { f32x4 ya[2], yb[2]; v4u xr[2], zr[2], m4, a4, b4; };
__device__ __forceinline__ void p5_load(P5Row& R, const P5In& I, int t, int lane) {
#pragma unroll
    for (int g = 0; g < 2; ++g) { const int ch = g * 512 + 8 * lane;
        R.ya[g] = *(const f32x4*)(I.yraw + (size_t)t * 1024 + ch); R.yb[g] = *(const f32x4*)(I.yraw + (size_t)t * 1024 + ch + 4);
        R.xr[g] = *(const v4u*)(I.xc + (size_t)t * 1536 + ch); R.zr[g] = *(const v4u*)(I.proj + (size_t)t * NPROJ + C_Z + ch); }
    R.m4 = *(const v4u*)(I.moba + (size_t)t * 512 + 8 * lane);
    const int dh = lane >> 4, dd = 8 * (lane & 15);
    R.a4 = *(const v4u*)(I.diff + (size_t)t * 1024 + (dh * 2 + 0) * 128 + dd); R.b4 = *(const v4u*)(I.diff + (size_t)t * 1024 + (dh * 2 + 1) * 128 + dd);
}
__device__ __forceinline__ void p5_put8(const P5In& I, size_t off, const float (&v)[8], float r, const f32x4& g0, const f32x4& g1) {
#if OUTPROJ_FP8
    const float r8 = r * pg8::A8_SCALE; v2u o; o.x = pg8::pk4_fp8(v[0] * r8 * g0[0], v[1] * r8 * g0[1], v[2] * r8 * g0[2], v[3] * r8 * g0[3]); o.y = pg8::pk4_fp8(v[4] * r8 * g1[0], v[5] * r8 * g1[1], v[6] * r8 * g1[2], v[7] * r8 * g1[3]);
    *(v2u*)(I.y + off) = o;
#else
    v4u o; o.x = pk2(v[0] * r * g0[0], v[1] * r * g0[1]); o.y = pk2(v[2] * r * g0[2], v[3] * r * g0[3]); o.z = pk2(v[4] * r * g1[0], v[5] * r * g1[1]); o.w = pk2(v[6] * r * g1[2], v[7] * r * g1[3]);
    *(v4u*)((bf16*)I.y + off) = o;
#endif
}
struct P5Par { float D[2]; f32x4 gs[2][2], gm[2], gd[2]; float lam; };
__device__ __forceinline__ void p5_item(const P5Row& R, const P5In& I, const P5Par& P, int t, int lane) {
#pragma unroll
    for (int g = 0; g < 2; ++g) { const int ch = g * 512 + 8 * lane;
        const f32x4 y0 = R.ya[g], y1 = R.yb[g]; const v4u xv = R.xr[g], zv = R.zr[g];
        const float D = P.D[g];
        float v[8];
        v[0] = (y0[0] + D * bflo(xv.x)) * siluf(bflo(zv.x)); v[1] = (y0[1] + D * bfhi(xv.x)) * siluf(bfhi(zv.x));
        v[2] = (y0[2] + D * bflo(xv.y)) * siluf(bflo(zv.y)); v[3] = (y0[3] + D * bfhi(xv.y)) * siluf(bfhi(zv.y));
        v[4] = (y1[0] + D * bflo(xv.z)) * siluf(bflo(zv.z)); v[5] = (y1[1] + D * bfhi(xv.z)) * siluf(bfhi(zv.z));
        v[6] = (y1[2] + D * bflo(xv.w)) * siluf(bflo(zv.w)); v[7] = (y1[3] + D * bfhi(xv.w)) * siluf(bfhi(zv.w));
        float s = 0.f;
#pragma unroll
        for (int i = 0; i < 8; ++i) s += v[i] * v[i];
        s = wave_sum(s); const float r = 1.0f / sqrtf(s * (1.0f / 512.0f) + EPSF);
        p5_put8(I, (size_t)t * DM + ch, v, r, P.gs[g][0], P.gs[g][1]); }
    { const int ch = 8 * lane; const v4u r4 = R.m4;
      float v[8] = {bflo(r4.x), bfhi(r4.x), bflo(r4.y), bfhi(r4.y), bflo(r4.z), bfhi(r4.z), bflo(r4.w), bfhi(r4.w)}; float s = 0.f;
#pragma unroll
      for (int i = 0; i < 8; ++i) s += v[i] * v[i];
      s += __shfl_xor(s, 1); s += __shfl_xor(s, 2); s += __shfl_xor(s, 4);
      const float r = 1.0f / sqrtf(s * (1.0f / 64.0f) + EPSF);
      p5_put8(I, (size_t)t * DM + 1024 + ch, v, r, P.gm[0], P.gm[1]); }
    { const int h = lane >> 4, d = 8 * (lane & 15); const v4u a4 = R.a4, b4 = R.b4; const float lam = P.lam;
      float v[8] = {bflo(a4.x) - lam * bflo(b4.x), bfhi(a4.x) - lam * bfhi(b4.x), bflo(a4.y) - lam * bflo(b4.y), bfhi(a4.y) - lam * bfhi(b4.y),
                    bflo(a4.z) - lam * bflo(b4.z), bfhi(a4.z) - lam * bfhi(b4.z), bflo(a4.w) - lam * bflo(b4.w), bfhi(a4.w) - lam * bfhi(b4.w)}; float s = 0.f;
#pragma unroll
      for (int i = 0; i < 8; ++i) s += v[i] * v[i];
      s += __shfl_xor(s, 1); s += __shfl_xor(s, 2); s += __shfl_xor(s, 4); s += __shfl_xor(s, 8);
      const float r = (1.0f - I.lambda_init) / sqrtf(s * (1.0f / 128.0f) + EPSF);
      p5_put8(I, (size_t)t * DM + 1536 + h * 128 + d, v, r, P.gd[0], P.gd[1]); }
}
__device__ __forceinline__ void p5_finalize(const Ctx& X, const P5In& I) {
    P5Par P;
    { const float a = wave_sum(I.lamp[X.lane] * I.lamp[64 + X.lane]), b = wave_sum(I.lamp[128 + X.lane] * I.lamp[192 + X.lane]); P.lam = __expf(a) - __expf(b) + I.lambda_init; }
#pragma unroll
    for (int g = 0; g < 2; ++g) { const int ch = g * 512 + 8 * X.lane; P.D[g] = I.d_skip[ch >> 6]; P.gs[g][0] = *(const f32x4*)(I.ssd_g + ch); P.gs[g][1] = *(const f32x4*)(I.ssd_g + ch + 4); }
    P.gm[0] = *(const f32x4*)(I.moba_g + 8 * X.lane); P.gm[1] = *(const f32x4*)(I.moba_g + 8 * X.lane + 4);
    P.gd[0] = *(const f32x4*)(I.subln_g + 8 * (X.lane & 15)); P.gd[1] = *(const f32x4*)(I.subln_g + 8 * (X.lane & 15) + 4);
    P5Row A, B;
    p5_load(A, I, X.gw < NTOK ? X.gw : NTOK - 1, X.lane);
    for (int t = X.gw; t < NTOK; t += 2 * X.ngw) { const int t1 = t + X.ngw, t2 = t + 2 * X.ngw;
        p5_load(B, I, t1 < NTOK ? t1 : NTOK - 1, X.lane);
        p5_item(A, I, P, t, X.lane);
        p5_load(A, I, t2 < NTOK ? t2 : NTOK - 1, X.lane);
        if (t1 < NTOK) p5_item(B, I, P, t1, X.lane); }
}

__device__ __forceinline__ void moe_tab(const Ctx& X, const unsigned* cnt, LAS int* tab) {
    __syncthreads();
    if (X.tid < 64) {
        int n = X.tid < 8 ? (int)((__hip_atomic_load(cnt + (X.tid & 7), RLX_AGENT) + 255u) >> 8) : 0, inc = n;
#pragma unroll
        for (int o = 1; o < 8; o <<= 1) { const int v = __shfl_up(inc, o); if ((X.tid & 63) >= o) inc += v; }
        if (X.tid < 8) tab[X.tid] = inc - n;
        if (X.tid == 7) tab[8] = inc; }
    __syncthreads();
}
__device__ __forceinline__ void moe_gather(const Ctx& X, const unsigned char* __restrict__ H8, const unsigned* __restrict__ route, const LAS int* tab, unsigned char* __restrict__ XG8) {
    for (int t = X.gw; t < NTOK; t += X.ngw) {
        const unsigned* rt = route + (size_t)t * 8;
        const int r0 = tab[rt[0]] * 256 + (int)rt[2], r1 = tab[rt[1]] * 256 + (int)rt[3];
        const v4u* src = (const v4u*)(H8 + (size_t)t * DM) + X.lane;
        v4u* d0 = (v4u*)(XG8 + (size_t)r0 * DM) + X.lane; v4u* d1 = (v4u*)(XG8 + (size_t)r1 * DM) + X.lane;
#pragma unroll
        for (int j = 0; j < 2; ++j) { const v4u v = src[64 * j]; d0[64 * j] = v; d1[64 * j] = v; }
    }
}
__device__ __forceinline__ void moe_combine_final(const Ctx& X, const bf16* __restrict__ XA, const bf16* __restrict__ YG, const bf16* __restrict__ TAIL, int lfull, const unsigned* __restrict__ route, const LAS int* tab,
                                                  const float* __restrict__ gate, const float* __restrict__ fg, float* __restrict__ out) {
    LAS int* tailid = (LAS int*)(X.lds);
    for (int i = X.tid; i < 576; i += 512) tailid[i] = -1;
    __syncthreads();
    { const int nwg = tab[8] * 8, ntail = nwg > lfull ? nwg - lfull : 0;
      if (X.tid < ntail) { int pm, e, j; pg8::moe_unit_map(tab, 8, lfull + X.tid, pm, e, j); tailid[pm * 8 + j] = X.tid; } }
    __syncthreads();
    for (int t = X.gw; t < NTOK; t += X.ngw) {
        const unsigned* rt = route + (size_t)t * 8;
        const int r0 = tab[rt[0]] * 256 + (int)rt[2], r1 = tab[rt[1]] * 256 + (int)rt[3];
        const float w0 = __uint_as_float(rt[4]), w1 = __uint_as_float(rt[5]);
        v2u xr_[8], ar_[8], br_[8]; int ta[8], tb[8];
#pragma unroll
        for (int j = 0; j < 8; ++j) { ta[j] = tailid[(r0 >> 8) * 8 + j]; tb[j] = tailid[(r1 >> 8) * 8 + j]; }
#pragma unroll
        for (int j = 0; j < 8; ++j) { const int c = 4 * X.lane + 256 * j;
            xr_[j] = *(const v2u*)(XA + (size_t)t * DM + c);
            const bf16* pa = ta[j] < 0 ? YG + (size_t)r0 * DM + c : TAIL + (size_t)ta[j] * 65536 + (size_t)(r0 & 255) * 256 + 4 * X.lane;
            const bf16* pb = tb[j] < 0 ? YG + (size_t)r1 * DM + c : TAIL + (size_t)tb[j] * 65536 + (size_t)(r1 & 255) * 256 + 4 * X.lane;
            ar_[j] = *(const v2u*)pa; br_[j] = *(const v2u*)pb; }
        f32x4 v[8]; float s = 0.f;
#pragma unroll
        for (int j = 0; j < 8; ++j) { const int c = 4 * X.lane + 256 * j;
            const f32x4 x = {bflo(xr_[j].x), bfhi(xr_[j].x), bflo(xr_[j].y), bfhi(xr_[j].y)}, g = *(const f32x4*)(gate + c);
            f32x4 ya = {bflo(ar_[j].x), bfhi(ar_[j].x), bflo(ar_[j].y), bfhi(ar_[j].y)}, yb = {bflo(br_[j].x), bfhi(br_[j].x), bflo(br_[j].y), bfhi(br_[j].y)};
            if (ta[j] >= 0) { const bf16* p = TAIL + (size_t)ta[j] * 65536 + (size_t)(r0 & 255) * 256 + 4 * X.lane;
#pragma unroll
                for (int kp = 1; kp < 7; ++kp) { const v2u a = *(const v2u*)(p + (size_t)kp * 64 * 65536); ya += (f32x4){bflo(a.x), bfhi(a.x), bflo(a.y), bfhi(a.y)}; } }
            if (tb[j] >= 0) { const bf16* p = TAIL + (size_t)tb[j] * 65536 + (size_t)(r1 & 255) * 256 + 4 * X.lane;
#pragma unroll
                for (int kp = 1; kp < 7; ++kp) { const v2u b = *(const v2u*)(p + (size_t)kp * 64 * 65536); yb += (f32x4){bflo(b.x), bfhi(b.x), bflo(b.y), bfhi(b.y)}; } }
            v[j] = x + g * (ya * w0 + yb * w1); s += (v[j][0] * v[j][0] + v[j][1] * v[j][1]) + (v[j][2] * v[j][2] + v[j][3] * v[j][3]); }
        s = wave_sum(s); const float r = 1.0f / sqrtf(s * (1.0f / DM) + EPSF);
#pragma unroll
        for (int j = 0; j < 8; ++j) { const int c = 4 * X.lane + 256 * j; const f32x4 g = *(const f32x4*)(fg + c); *(f32x4*)(out + (size_t)t * DM + c) = v[j] * r * g; }
    }
}
struct Args { const void* in[27]; float* out; unsigned char* ws; int ph_lo, ph_hi, li, pad; };
using EpiUpD = pg8::EpiSwiGLU<44, FFD, true>; using EpiUpE = pg8::EpiSwiGLU<56, FFE>; using EpiDnE = pg8::EpiPlain<8, DM>;
#define GEMM_MULTI(EPI, SCH) pg8::gemm_phase<EPI, SCH, true, true>
#define GEMM_SINGLE(EPI, SCH) pg8::gemm_phase<EPI, SCH, false, true>
#define GEMM_MULTI8(EPI, SCH) pg8::gemm_phase<EPI, SCH, true, true, true>
#define GEMM_SINGLE8(EPI, SCH) pg8::gemm_phase<EPI, SCH, false, true, true>
#if MK_MULTI
#define GRID_BAR() do { } while (0)
#else
#define GRID_BAR() xcd_barrier(bar)
#endif
#define IN(k) (lo <= (k) && (k) < hi)
#define SEAM(k) do { if (IN(k) && IN((k) + 1)) GRID_BAR(); } while (0)
#ifndef PROBE_REP
#define PROBE_REP -1
#endif
#define REPS(P) for (int rep_ = 0; rep_ < ((P) == PROBE_REP ? 2 : 1); ++rep_)
#define REPBAR() do { if (rep_) GRID_BAR(); } while (0)
template <int l>
__device__ __forceinline__ void layer_body(unsigned char* lds_raw, const Args& args, const XcdBarrier& bar, const int lo, const int hi) {
    unsigned char* ws = args.ws;
    unsigned* ctl = (unsigned*)(ws + WS_CTL);
    LAS int* tab = (LAS int*)((LAS unsigned char*)lds_raw + LDSCTL_OFF + 256);
    volatile LAS unsigned* MISC = (volatile LAS unsigned*)((LAS unsigned char*)lds_raw + LDSCTL_OFF);
    const float* x_in = (const float*)args.in[0];
    const int* positions = (const int*)args.in[2];
    const float* rel_bias = (const float*)args.in[3];
    bf16* Hb = (bf16*)(ws + WS_H); bf16* PROJ = (bf16*)(ws + WS_PROJ); bf16* XC = (bf16*)(ws + WS_XC); bf16* Yb = (bf16*)(ws + WS_Y);
    bf16* MOBA = (bf16*)(ws + WS_MOBA); bf16* DIFF = (bf16*)(ws + WS_DIFF); bf16* Gb = (bf16*)(ws + WS_G); bf16* XG = (bf16*)(ws + WS_XG); bf16* YG = (bf16*)(ws + WS_YG);
    bf16* XA = (bf16*)(ws + WS_XA); float* YRAW = (float*)(ws + WS_YRAW); float* DT = (float*)(ws + WS_DT); float* DTV = (float*)(ws + WS_DTV); float* ACS = (float*)(ws + WS_ACS);
    float* KM = (float*)(ws + WS_KM); float* MOD = (float*)(ws + WS_MOD); const float* MODP = (const float*)(ws + WS_MODP);
    unsigned* ROUTE = (unsigned*)(ws + WS_ROUTE);

        constexpr int pb = l == 0 ? 1 : 12;
        const float* modl = MOD + (size_t)l * NMOD;
        const float lambda_init = l == 0 ? 0.2f : 0.8f - 0.6f * 0.7408182206817179f;
        if (IN(pb + 0)) REPS(pb + 0) { REPBAR(); const Ctx X = make_ctx(lds_raw);
            const float* b_ada = (const float*)args.in[5] + (size_t)l * NMOD; const float* g1 = (const float*)args.in[6] + (size_t)l * DM;
            for (int e = X.gtid; e < NMOD; e += X.ngt) { float m[5]; m[0] = b_ada[e];
#pragma unroll
                for (int ks = 0; ks < 4; ++ks) m[1 + ks] = MODP[(size_t)(ks * 2 + l) * NMOD + e];
                asm volatile("" ::: "memory");
                MOD[(size_t)l * NMOD + e] = (((m[0] + m[1]) + m[2]) + m[3]) + m[4]; }
            LAS float* sh = (LAS float*)(X.lds); LAS float* gs = (LAS float*)(X.lds + 8192);
            { float a0[4], a1[4], gg[4], m0[4][4], m1[4][4];
#pragma unroll
              for (int q = 0; q < 4; ++q) { const int c = X.tid + 512 * q; a0[q] = b_ada[c]; a1[q] = b_ada[DM + c]; gg[q] = g1[c];
#pragma unroll
                  for (int ks = 0; ks < 4; ++ks) { m0[q][ks] = MODP[(size_t)(ks * 2 + l) * NMOD + c]; m1[q][ks] = MODP[(size_t)(ks * 2 + l) * NMOD + DM + c]; } }
              asm volatile("" ::: "memory");
#pragma unroll
              for (int q = 0; q < 4; ++q) { const int c = X.tid + 512 * q; float s0 = a0[q], s1 = a1[q];
#pragma unroll
                  for (int ks = 0; ks < 4; ++ks) { s0 += m0[q][ks]; s1 += m1[q][ks]; }
                  sh[c] = s0; gs[c] = gg[q] * (1.0f + s1); } }
            __syncthreads();
            if (l == 0) rms_rows<false, true, false>(X, x_in, Hb, sh, gs, nullptr, nullptr, nullptr); else rms_rows<false, true, true>(X, XA, Hb, sh, gs, nullptr, nullptr, nullptr);
            __syncthreads();
        }
        SEAM(pb + 0);
        if (IN(pb + 1)) REPS(pb + 1) { REPBAR(); const Ctx X = make_ctx(lds_raw);
            pg8::Gemm g{Hb, (const bf16*)(ws + WS_WIN + (size_t)l * NPROJ_T * DM), NTOK, NPROJ_T, DM / 2}; pg8::StaticOrder S; S.init(NTOK, NPROJ_T, X.G, X.bx);
            pg8::EpiProj E{PROJ, DT, pg8::ACC8_INV};
            GEMM_MULTI8(pg8::EpiProj, pg8::StaticOrder)(X.lds + RING_OFF, g, S, E);
        }
        SEAM(pb + 1);
        if (IN(pb + 2)) REPS(pb + 2) { REPBAR(); const Ctx X = make_ctx(lds_raw);
            P3In I{PROJ, DT, (const float*)args.in[8] + (size_t)l * 4 * 1536, (const float*)args.in[9] + (size_t)l * 1536, (const float*)args.in[10] + l * 16, (const float*)args.in[11] + l * 16, XC, DTV, ACS, KM};
            p3_conv(X, I);
        }
        SEAM(pb + 2);
        if (IN(pb + 3)) { const Ctx X = make_ctx(lds_raw);
            for (int u = X.bx; u < 512; u += X.G) ssd_a_unit(X, XC, DTV, ACS, YRAW, (float*)(ws + WS_SST), u >> 4, u & 15);
            __syncthreads();
            const DefIn DI{(const float*)args.in[19], (const float*)args.in[20], (const float*)args.in[21], (const float*)args.in[23], (const float*)args.in[24], (const float*)args.in[25], ws};
            const P0In PI{(const float*)args.in[1], (const float*)args.in[4], (const float*)args.in[7], (const float*)args.in[17], nullptr, nullptr, nullptr, nullptr, nullptr, nullptr, ws};
            attn_phase(X, PROJ, KM, positions, rel_bias, MOBA, DIFF, ctl + CW_Q + 1024 * l, MISC + 16, DI, l * DEF_ITEMS_L, PI, l == 0 ? EXTRA_ITEMS : 0);
            __syncthreads();
        }
        SEAM(pb + 3);
        if (IN(pb + 4)) REPS(pb + 4) { const Ctx X = make_ctx(lds_raw); ssd_scan(X, (const float*)(ws + WS_SST), ACS, (bf16*)(ws + WS_HPREV));
            if (l == 0) bias_gemv8(X, ws + WS_W13, modl + 3 * DM, (float*)(ws + WS_BIASU), 2 * FFD); }
        SEAM(pb + 4);
        if (IN(pb + 5)) REPS(pb + 5) { REPBAR(); const Ctx X = make_ctx(lds_raw); for (int u = 16 + X.bx; u < 512; u += X.G) ssd_c_unit(X, XC, ACS, (const bf16*)(ws + WS_HPREV), YRAW, u >> 4, u & 15); }
        SEAM(pb + 5);
        if (IN(pb + 6)) REPS(pb + 6) { REPBAR(); const Ctx X = make_ctx(lds_raw);
            P5In I{YRAW, XC, PROJ, MOBA, DIFF, (const float*)args.in[12] + l * 16, (const float*)args.in[13] + (size_t)l * 1024, (const float*)args.in[14] + (size_t)l * 512,
                   (const float*)args.in[15] + (size_t)l * 256, (const float*)args.in[16] + (size_t)l * 128, lambda_init, (unsigned char*)Yb};
            p5_finalize(X, I);
        }
        SEAM(pb + 6);
        if (IN(pb + 7)) REPS(pb + 7) { REPBAR(); const Ctx X = make_ctx(lds_raw);
#if OUTPROJ_FP8
            pg8::Gemm g{Yb, (const bf16*)(ws + WS_WOUT + (size_t)l * DM * DM), NTOK, DM, DM / 2}; pg8::StaticOrder S; S.init(NTOK, DM, X.G, X.bx);
            if (l == 0) { typedef pg8::EpiResid<false, true> EpiO0; EpiO0 E{x_in, XA, modl + 2 * DM, pg8::ACC8_INV, (unsigned char*)Hb, (const float*)args.in[18], modl + 4 * DM, (float*)(ws + WS_ROWP), (LAS float*)(X.lds + 131072)};
                GEMM_MULTI8(EpiO0, pg8::StaticOrder)(X.lds + RING_OFF, g, S, E); }
            else { pg8::EpiResid<true> E{XA, XA, modl + 2 * DM, pg8::ACC8_INV, nullptr, nullptr, nullptr, nullptr, nullptr}; GEMM_SINGLE8(pg8::EpiResid<true>, pg8::StaticOrder)(X.lds + RING_OFF, g, S, E); }
#else
            pg8::Gemm g{Yb, (const bf16*)(ws + WS_WOUT) + (size_t)l * DM * DM, NTOK, DM, DM}; pg8::StaticOrder S; S.init(NTOK, DM, X.G, X.bx);
            if (l == 0) { typedef pg8::EpiResid<false, true> EpiO0; EpiO0 E{x_in, XA, modl + 2 * DM, 1.0f, (unsigned char*)Hb, (const float*)args.in[18], modl + 4 * DM, (float*)(ws + WS_ROWP), (LAS float*)(X.lds + 131072)};
                GEMM_MULTI(EpiO0, pg8::StaticOrder)(X.lds + RING_OFF, g, S, E); }
            else { pg8::EpiResid<true> E{XA, XA, modl + 2 * DM, 1.0f, nullptr, nullptr, nullptr, nullptr, nullptr}; GEMM_SINGLE(pg8::EpiResid<true>, pg8::StaticOrder)(X.lds + RING_OFF, g, S, E); }
#endif
        }
        SEAM(pb + 7);
        if (l == 1) {
        if (IN(pb + 8)) REPS(pb + 8) { REPBAR(); const Ctx X = make_ctx(lds_raw);
            const float* g2 = (const float*)args.in[18] + (size_t)l * DM;
            LAS float* sh = (LAS float*)(X.lds); LAS float* gs = (LAS float*)(X.lds + 8192);
            for (int c = X.tid; c < DM; c += 512) { sh[c] = modl[3 * DM + c]; gs[c] = g2[c] * (1.0f + modl[4 * DM + c]); }
            LAS float* rwL = (LAS float*)(X.lds + 16384);
            { const float* rw = (const float*)args.in[22]; for (int i = X.tid; i < DM * 8; i += 512) rwL[(i & 7) * DM + (i >> 3)] = rw[i]; }
            __syncthreads();
            rms_rows<true, true, true>(X, XA, ws + WS_XG8S, sh, gs, rwL, ctl + CW_CNT, ROUTE);
            __syncthreads();
        }
        SEAM(pb + 8);
        }
        if (l == 0) {
            if (IN(10)) REPS(10) { REPBAR(); const Ctx X = make_ctx(lds_raw);
                pg8::Gemm g{Hb, (const bf16*)(ws + WS_W13), NTOK, 2 * FFD, DM / 2}; pg8::StaticOrder S; S.init(NTOK, 2 * FFD, X.G, X.bx);
                EpiUpD E{(unsigned char*)Gb, (const float*)(ws + WS_ROWP), (const float*)(ws + WS_BIASU)};
                GEMM_MULTI8(EpiUpD, pg8::StaticOrder)(X.lds + RING_OFF, g, S, E);
            }
            SEAM(10);
            if (IN(11)) REPS(11) { REPBAR(); const Ctx X = make_ctx(lds_raw);
                pg8::Gemm g{Gb, (const bf16*)(ws + WS_W2), NTOK, DM, FFD / 2}; pg8::StaticOrder S; S.init(NTOK, DM, X.G, X.bx);
                pg8::EpiResid<true> E{XA, XA, modl + 5 * DM, pg8::ACC8_INV, nullptr, nullptr, nullptr, nullptr, nullptr};
                GEMM_SINGLE8(pg8::EpiResid<true>, pg8::StaticOrder)(X.lds + RING_OFF, g, S, E);
            }
            SEAM(11);
        } else {
            if (IN(22)) REPS(22) { REPBAR(); const Ctx X = make_ctx(lds_raw);
                moe_tab(X, ctl + CW_CNT, tab);
                pg8::Gemm g{(const bf16*)(ws + WS_XG8S), (const bf16*)(ws + WS_W13E), 8 * NTOK, 8 * 2 * FFE, DM / 2}; if (X.tid < 32) pg8::GroupedOrder::build(tab + 16, tab, 56, 1, 0, NTOK / 256, X.G, X.bx, X.tid); __syncthreads(); pg8::GroupedOrder S{tab + 16};
                EpiUpE E{(unsigned char*)Gb, nullptr, nullptr};
                GEMM_MULTI8(EpiUpE, pg8::GroupedOrder)(X.lds + RING_OFF, g, S, E);
            }
            SEAM(22);
            if (IN(23)) REPS(23) { REPBAR(); const Ctx X = make_ctx(lds_raw);
                moe_tab(X, ctl + CW_CNT, tab);
                { pg8::Gemm g{Gb, (const bf16*)(ws + WS_W2E), MAXROWS, 8 * DM, FFE / 2}; if (X.tid < 32) pg8::GroupedOrder::build_full(tab + 16, tab, 8, 2 * X.G, X.G, X.bx, X.tid); __syncthreads(); pg8::GroupedOrder S{tab + 16};
                  EpiDnE E{YG};
                  GEMM_MULTI8(EpiDnE, pg8::GroupedOrder)(X.lds + RING_OFF, g, S, E); }
                __syncthreads();
                { pg8::Gemm g{Gb, (const bf16*)(ws + WS_W2E), MAXROWS, 8 * DM, FFE / 2, FFE / 14}; if (X.tid < 32) pg8::GroupedOrder::build_tail(tab + 16, tab, 8, 2 * X.G, 7, FFE / 7, X.G, X.bx, X.tid); __syncthreads(); pg8::GroupedOrder S{tab + 16};
                  pg8::EpiTail E{(bf16*)(ws + WS_YG2)};
                  GEMM_MULTI8(pg8::EpiTail, pg8::GroupedOrder)(X.lds + RING_OFF, g, S, E); }
            }
            SEAM(23);
            if (IN(24)) REPS(24) { REPBAR(); const Ctx X = make_ctx(lds_raw); moe_tab(X, ctl + CW_CNT, tab); moe_combine_final(X, XA, YG, (const bf16*)(ws + WS_YG2), 2 * X.G, ROUTE, tab, modl + 5 * DM, (const float*)args.in[26], args.out); }
        }
    }
__global__ void __launch_bounds__(NWAVES * 64, 2) fwd(Args args) {
    extern __shared__ __attribute__((aligned(16))) unsigned char lds_raw[];
    unsigned char* ws = args.ws;
    unsigned* ctl = (unsigned*)(ws + WS_CTL);
    volatile LAS unsigned* MISC = (volatile LAS unsigned*)((LAS unsigned char*)lds_raw + LDSCTL_OFF);
    for (int u = threadIdx.x; u < (LDS_BYTES - LDSCTL_OFF) / 4; u += NWAVES * 64) ((LAS unsigned*)((LAS unsigned char*)lds_raw + LDSCTL_OFF))[u] = 0u;
    __syncthreads();
#if MK_MULTI
    XcdBarrier bar; bar.bar = ctl + CW_BAR; bar.x = 0; bar.st = MISC + 8;
#else
    XcdBarrier bar = xcd_barrier_post(ctl + CW_BAR, MISC + 8);
#endif
    const int lo = args.ph_lo, hi = args.ph_hi;

    if (IN(0)) REPS(0) { REPBAR(); const Ctx X = make_ctx(lds_raw);
        P0In I{(const float*)args.in[1], (const float*)args.in[4], (const float*)args.in[7], (const float*)args.in[17], (const float*)args.in[19], (const float*)args.in[20], (const float*)args.in[21],
               (const float*)args.in[23], (const float*)args.in[24], (const float*)args.in[25], ws};
        p0_prologue(X, I);
    }
    SEAM(0);

    layer_body<0>(lds_raw, args, bar, lo, hi);
    layer_body<1>(lds_raw, args, bar, lo, hi);
#undef IN
#undef SEAM
}

extern "C" void kernel_launch(void* const* d_in, const int* in_sizes, int n_in, void* d_out, int out_size, void* d_ws, size_t ws_size, hipStream_t stream) {
    static int grid = 0;
    if (grid == 0) {
        if (n_in != 27 || in_sizes[0] != NTOK * DM || out_size != NTOK * DM || ws_size < WS_END) {
            fprintf(stderr, "kernel_launch: expected 27 inputs, x/out of %d floats, >= %zu bytes of workspace; got n_in %d, in0 %d, out %d, ws %zu; nothing launched\n", NTOK * DM, (size_t)WS_END, n_in, n_in > 0 ? in_sizes[0] : -1, out_size, ws_size);
            grid = -1; return; }
        int dev = 0, cus = 0, per_cu = 0;
        if (hipGetDevice(&dev) != hipSuccess || hipDeviceGetAttribute(&cus, hipDeviceAttributeMultiprocessorCount, dev) != hipSuccess) { fprintf(stderr, "kernel_launch: device query failed\n"); grid = -1; return; }
        if (hipFuncSetAttribute((const void*)fwd, hipFuncAttributeMaxDynamicSharedMemorySize, LDS_BYTES) != hipSuccess) { fprintf(stderr, "kernel_launch: hipFuncSetAttribute failed\n"); grid = -1; return; }
        if (hipOccupancyMaxActiveBlocksPerMultiprocessor(&per_cu, (const void*)fwd, NWAVES * 64, LDS_BYTES) != hipSuccess || per_cu < 1)
            fprintf(stderr, "kernel_launch: note: occupancy query reports %d workgroups per CU\n", per_cu);
        (void)hipGetLastError();
        grid = cus;
    }
    if (grid < 0) return;
    if (hipMemsetAsync((char*)d_ws + WS_CTL, 0, CTL_ZERO_BYTES, stream) != hipSuccess) { fprintf(stderr, "kernel_launch: memset failed\n"); return; }
    Args a{};
    for (int i = 0; i < 27; ++i) a.in[i] = d_in[i];
    a.out = (float*)d_out; a.ws = (unsigned char*)d_ws; a.li = 0; a.pad = 0;
#if MK_MULTI
    for (int p = 0; p < NPHASE; ++p) { a.ph_lo = p; a.ph_hi = p + 1; hipLaunchKernelGGL(fwd, dim3(grid), dim3(NWAVES * 64), LDS_BYTES, stream, a); }
#else
    a.ph_lo = 0; a.ph_hi = NPHASE;
    hipLaunchKernelGGL(fwd, dim3(grid), dim3(NWAVES * 64), LDS_BYTES, stream, a);
#endif
    const hipError_t le = hipPeekAtLastError();
    if (le != hipSuccess) fprintf(stderr, "kernel_launch: launch failed: %s\n", hipGetErrorName(le));
}
```

```cpp
#include <hip/hip_runtime.h>
#include <cstdio>
#include <cstdint>
#ifndef OUTPROJ_FP8
#define OUTPROJ_FP8 1
#endif
#ifndef MK_MULTI
#define MK_MULTI 0
#endif
namespace pg8 {
#define PG8_LAS __attribute__((address_space(3)))
typedef unsigned short bf16_t;
typedef short bf16x8 __attribute__((ext_vector_type(8)));
typedef float f32x4 __attribute__((ext_vector_type(4)));
typedef unsigned u32x4 __attribute__((ext_vector_type(4)));
constexpr int BM = 256, BK = 64, HALF = 128, HTB = HALF * BK * 2  , STAGE_BYTES = 8 * HTB, NXCD = 8, WGM = 8;

__host__ __device__ __forceinline__ int lds_byte(int r, int c) { const int st = (r >> 4) * 2 + (c >> 5), rr = r & 15, cc = c & 31, ob = rr * 64 + cc * 2; return st * 1024 + (ob ^ (((ob >> 9) & 1) << 5)); }
__host__ __device__ __forceinline__ void stage_rc(int b, int& R, int& C) { const int st = b / 1024, sb = b % 1024, swz = sb ^ (((sb >> 9) & 1) << 5); R = (st >> 1) * 16 + swz / 64; C = (st & 1) * 32 + (swz % 64) / 2; }
__host__ __device__ __forceinline__ int perm32(int rho) { const int n = rho >> 4, i = rho & 15; return 8 * (i >> 2) + 4 * n + (i & 3); }

struct Unit { int pm, pn, ko, po; };
struct Gemm { const bf16_t* A; const bf16_t* Bt; int M, N, K, KS; };

struct StaticOrder {
    int nM, nN, nwg, G, c;
    __host__ __device__ void init(int M, int N, int G_, int c_) { nM = M / BM; nN = N / BM; nwg = nM * nN; G = G_; c = c_; }
    __host__ __device__ bool next(int i, Unit& u) const {
        const long L = (long)i * G + c; if (L >= nwg) return false;
        int wgid = (int)L; { const int q = nwg / NXCD, r = nwg % NXCD, xcd = wgid % NXCD, off = wgid / NXCD; wgid = (xcd < r ? xcd * (q + 1) : r * (q + 1) + (xcd - r) * q) + off; }
        const int nig = WGM * nN, gid = wgid / nig, fm = gid * WGM, gsz = (nM - fm) < WGM ? (nM - fm) : WGM;
        u.pm = fm + ((wgid % nig) % gsz); u.pn = (wgid % nig) / gsz; u.ko = 0; u.po = u.pm; return true;
    }
    __device__ __forceinline__ void a_ready(const Unit&) const {}
    __device__ __forceinline__ void done(const Unit&) const {}
};
__device__ __forceinline__ unsigned cvt_pk_bf16(float lo, float hi) { unsigned r; asm volatile("v_cvt_pk_bf16_f32 %0, %1, %2" : "=v"(r) : "v"(lo), "v"(hi)); return r; }
typedef float f32x2 __attribute__((ext_vector_type(2)));
typedef int pg8_v8i __attribute__((ext_vector_type(8))); typedef int pg8_v4i __attribute__((ext_vector_type(4)));
template <class Epi, class Sched, bool ALIGN_EPI = false, bool SP2 = false, bool FP8 = false>
__device__ __forceinline__ void gemm_phase(PG8_LAS unsigned char* lds, const Gemm g, const Sched& S, const Epi& E) {
    const int tid = threadIdx.x, wid = __builtin_amdgcn_readfirstlane(tid >> 6), lane = tid & 63, wr = wid >> 2, wc = wid & 3, fr = lane & 15, fq = lane >> 4;
    const int K = g.K, nt = (g.KS ? g.KS : K) / BK;
    unsigned voffA[1], voffB[1];
    { int R, C; stage_rc(tid * 16, R, C); const int Rb = Epi::PERM ? ((R & ~31) + perm32(R & 31)) : R;
        voffA[0] = (unsigned)(R * K + C) * 2u; voffB[0] = (unsigned)(Rb * K + C) * 2u; }
    const size_t qstep = (size_t)64 * K * 2;
    const size_t kstep = (size_t)(BK * 2);
    const size_t hstep = (size_t)HALF * K * 2;
    const size_t tstep = 2 * hstep;
    const unsigned ldsw = (unsigned)wid * 1024u;
    const int aoff = lds_byte(wr * 64 + fr, fq * 8), boff = lds_byte(wc * 32 + fr, fq * 8);
#define PG8_SA(b, h) (((b) * 2 + (h)) * HTB)
#define PG8_SB(b, h) ((4 + (b) * 2 + (h)) * HTB)
#define PG8_STAGE(bufoff, gbase, voff) do { _Pragma("unroll") for (int _i = 0; _i < 2; ++_i) \
        __builtin_amdgcn_global_load_lds((const unsigned*)((const char*)(gbase) + _i * qstep + (voff)[0]), (PG8_LAS unsigned*)(lds + (bufoff) + ldsw + _i * 8192), 16, 0, 0); } while (0)
#define PG8_LDA(dst, b, h) do { if constexpr (FP8) { _Pragma("unroll") for (int m = 0; m < 4; ++m) { const pg8_v4i lo_ = *(const PG8_LAS pg8_v4i*)(lds + PG8_SA(b, h) + aoff + m * 2048), hi_ = *(const PG8_LAS pg8_v4i*)(lds + PG8_SA(b, h) + aoff + m * 2048 + 1024); \
        dst##8[m] = __builtin_shufflevector(lo_, hi_, 0, 1, 2, 3, 4, 5, 6, 7); } } else { _Pragma("unroll") for (int m = 0; m < 4; ++m) _Pragma("unroll") for (int k = 0; k < 2; ++k) dst[m][k] = *(const PG8_LAS bf16x8*)(lds + PG8_SA(b, h) + aoff + m * 2048 + k * 1024); } } while (0)
#define PG8_LDB(dst, b, h) do { if constexpr (FP8) { _Pragma("unroll") for (int n = 0; n < 2; ++n) { const pg8_v4i lo_ = *(const PG8_LAS pg8_v4i*)(lds + PG8_SB(b, h) + boff + n * 2048), hi_ = *(const PG8_LAS pg8_v4i*)(lds + PG8_SB(b, h) + boff + n * 2048 + 1024); \
        dst##8[n] = __builtin_shufflevector(lo_, hi_, 0, 1, 2, 3, 4, 5, 6, 7); } } else { _Pragma("unroll") for (int n = 0; n < 2; ++n) _Pragma("unroll") for (int k = 0; k < 2; ++k) dst[n][k] = *(const PG8_LAS bf16x8*)(lds + PG8_SB(b, h) + boff + n * 2048 + k * 1024); } } while (0)
#define PG8_MMA(ai, bj, At, Bt) do { __builtin_amdgcn_s_setprio(1); _Pragma("unroll") for (int m = 0; m < 4; ++m) _Pragma("unroll") for (int n = 0; n < 2; ++n) { \
        if constexpr (FP8) { asm volatile("v_mfma_f32_16x16x128_f8f6f4 %0, %1, %2, %0" : "+v"(acc[ai][bj][m][n]) : "v"(Bt##8[n]), "v"(At##8[m])); }     \
        else { _Pragma("unroll") for (int k = 0; k < 2; ++k) acc[ai][bj][m][n] = __builtin_amdgcn_mfma_f32_16x16x32_bf16(Bt[n][k], At[m][k], acc[ai][bj][m][n], 0, 0, 0); } } \
        __builtin_amdgcn_s_setprio(0); } while (0)
#define PG8_WAIT_V(n) asm volatile("s_waitcnt vmcnt(" #n ")" ::: "memory")
#define PG8_WAIT_L(n) asm volatile("s_waitcnt lgkmcnt(" #n ")" ::: "memory")
#define PG8_BAR __builtin_amdgcn_s_barrier()
#define PG8_SCHED __builtin_amdgcn_sched_barrier(0)
    Unit cur, nxt; int ui = 0;
    if (!S.next(0, cur)) return;
    f32x4 acc[2][2][4][2];
#pragma unroll
    for (int a = 0; a < 2; ++a)
#pragma unroll
        for (int b = 0; b < 2; ++b)
#pragma unroll
            for (int m = 0; m < 4; ++m)
#pragma unroll
                for (int n = 0; n < 2; ++n) acc[a][b][m][n] = (f32x4){0.f, 0.f, 0.f, 0.f};
    bf16x8 At[4][2], B0[2][2], B1[2][2]; pg8_v8i At8[4], B08[2], B18[2];
    const char* cA = (const char*)g.A + (size_t)cur.pm * tstep + cur.ko; const char* cB = (const char*)g.Bt + (size_t)cur.pn * tstep + cur.ko;
    S.a_ready(cur);
    if constexpr (SP2) {
        PG8_STAGE(PG8_SB(0, 0), cB, voffB); PG8_STAGE(PG8_SB(0, 1), cB + hstep, voffB); PG8_STAGE(PG8_SA(0, 0), cA, voffA); PG8_STAGE(PG8_SA(0, 1), cA + hstep, voffA);
        if (wr == 1) PG8_BAR;
        PG8_WAIT_V(2); PG8_BAR;
        PG8_STAGE(PG8_SB(1, 0), cB + kstep, voffB); PG8_STAGE(PG8_SA(1, 0), cA + kstep, voffA); PG8_STAGE(PG8_SB(1, 1), cB + hstep + kstep, voffB);
        PG8_WAIT_V(6); PG8_BAR;
    } else {
        PG8_STAGE(PG8_SB(0, 0), cB, voffB); PG8_STAGE(PG8_SA(0, 0), cA, voffA); PG8_STAGE(PG8_SB(0, 1), cB + hstep, voffB); PG8_STAGE(PG8_SA(0, 1), cA + hstep, voffA);
        if (wr == 1) PG8_BAR;
        PG8_WAIT_V(4); PG8_BAR;
        PG8_STAGE(PG8_SB(1, 0), cB + kstep, voffB); PG8_STAGE(PG8_SA(1, 0), cA + kstep, voffA); PG8_STAGE(PG8_SB(1, 1), cB + hstep + kstep, voffB);
        PG8_WAIT_V(6); PG8_BAR;
    }
    for (;;) {
        const bool has_next = S.next(ui + 1, nxt);
        const char* nA = has_next ? (const char*)g.A + (size_t)nxt.pm * tstep + nxt.ko : cA; const char* nB = has_next ? (const char*)g.Bt + (size_t)nxt.pn * tstep + nxt.ko : cB;
        for (int t = 0; t < nt; t += 2) {
            const bool last = (t == nt - 2);
            const char* a1 = cA + (size_t)(t + 1) * kstep;
            const char* a2 = last ? nA : cA + (size_t)(t + 2) * kstep; const char* b2 = last ? nB : cB + (size_t)(t + 2) * kstep;
            const char* a3 = a2 + kstep; const char* b3 = b2 + kstep;
            if (last && has_next) S.a_ready(nxt);
            if constexpr (SP2) {
            PG8_LDB(B0, 0, 0); PG8_LDB(B1, 0, 1); PG8_SCHED; PG8_LDA(At, 0, 0); PG8_STAGE(PG8_SA(1, 1), a1 + hstep, voffA);
            PG8_WAIT_V(8); PG8_WAIT_L(0); PG8_BAR; PG8_MMA(0, 0, At, B0); PG8_MMA(0, 1, At, B1); PG8_BAR; PG8_SCHED;
            PG8_LDA(At, 0, 1); PG8_STAGE(PG8_SB(0, 0), b2, voffB); PG8_STAGE(PG8_SB(0, 1), b2 + hstep, voffB); PG8_STAGE(PG8_SA(0, 0), a2, voffA);
            PG8_WAIT_V(8); PG8_WAIT_L(0); PG8_BAR; PG8_MMA(1, 0, At, B0); PG8_MMA(1, 1, At, B1); PG8_BAR; PG8_SCHED;
            PG8_LDB(B0, 1, 0); PG8_LDB(B1, 1, 1); PG8_SCHED; PG8_LDA(At, 1, 0); PG8_STAGE(PG8_SA(0, 1), a2 + hstep, voffA);
            PG8_WAIT_V(8); PG8_WAIT_L(0); PG8_BAR; PG8_MMA(0, 0, At, B0); PG8_MMA(0, 1, At, B1); PG8_BAR; PG8_SCHED;
            PG8_LDA(At, 1, 1); PG8_STAGE(PG8_SB(1, 0), b3, voffB); PG8_STAGE(PG8_SB(1, 1), b3 + hstep, voffB); PG8_STAGE(PG8_SA(1, 0), a3, voffA);
            PG8_WAIT_V(8); PG8_WAIT_L(0); PG8_BAR; PG8_MMA(1, 0, At, B0); PG8_MMA(1, 1, At, B1); PG8_BAR; PG8_SCHED;
            } else {
            PG8_LDB(B0, 0, 0); PG8_SCHED; PG8_LDA(At, 0, 0); PG8_STAGE(PG8_SA(1, 1), a1 + hstep, voffA);
            PG8_WAIT_L(8); PG8_BAR; PG8_WAIT_L(0); PG8_MMA(0, 0, At, B0); PG8_BAR; PG8_SCHED;
            PG8_LDB(B1, 0, 1); PG8_STAGE(PG8_SB(0, 0), b2, voffB);
            PG8_BAR; PG8_WAIT_L(0); PG8_MMA(0, 1, At, B1); PG8_BAR;
            PG8_LDA(At, 0, 1); PG8_STAGE(PG8_SA(0, 0), a2, voffA);
            PG8_BAR; PG8_WAIT_L(0); PG8_MMA(1, 0, At, B0); PG8_BAR; PG8_SCHED;
            PG8_STAGE(PG8_SB(0, 1), b2 + hstep, voffB);
            PG8_WAIT_V(6); PG8_BAR; PG8_MMA(1, 1, At, B1); PG8_BAR;
            PG8_LDB(B0, 1, 0); PG8_SCHED; PG8_LDA(At, 1, 0); PG8_STAGE(PG8_SA(0, 1), a2 + hstep, voffA);
            PG8_WAIT_L(8); PG8_BAR; PG8_WAIT_L(0); PG8_MMA(0, 0, At, B0); PG8_BAR; PG8_SCHED;
            PG8_LDB(B1, 1, 1); PG8_STAGE(PG8_SB(1, 0), b3, voffB);
            PG8_BAR; PG8_WAIT_L(0); PG8_MMA(0, 1, At, B1); PG8_BAR;
            PG8_LDA(At, 1, 1); PG8_STAGE(PG8_SA(1, 0), a3, voffA);
            PG8_BAR; PG8_WAIT_L(0); PG8_MMA(1, 0, At, B0); PG8_BAR; PG8_SCHED;
            PG8_STAGE(PG8_SB(1, 1), b3 + hstep, voffB);
            PG8_WAIT_V(6); PG8_BAR; PG8_MMA(1, 1, At, B1); PG8_BAR;
            }
        }
        if constexpr (ALIGN_EPI) { if (wr == 0) PG8_BAR; }
        if constexpr (FP8) { asm volatile("s_nop 15\n\ts_nop 15" ::: "memory"); }
        if constexpr (!Epi::AFTER_DRAIN) { E(acc, cur, wr, wc, fr, fq); S.done(cur); }
        if (!has_next) break;
#pragma unroll
        for (int a = 0; a < 2; ++a)
#pragma unroll
            for (int b = 0; b < 2; ++b)
#pragma unroll
                for (int m = 0; m < 4; ++m)
#pragma unroll
                    for (int n = 0; n < 2; ++n) acc[a][b][m][n] = (f32x4){0.f, 0.f, 0.f, 0.f};
        cur = nxt; cA = nA; cB = nB; ++ui;
        if constexpr (ALIGN_EPI) { if (wr == 1) PG8_BAR; }
    }
    PG8_WAIT_V(0);
    if constexpr (!ALIGN_EPI) { if (wr == 0) PG8_BAR; }
    PG8_BAR;
    if constexpr (Epi::AFTER_DRAIN) { E.fused(acc, cur, wr, wc, fr, fq, lds, wid, lane); S.done(cur); }
#undef PG8_SA
#undef PG8_SB
#undef PG8_STAGE
#undef PG8_LDA
#undef PG8_LDB
#undef PG8_MMA
#undef PG8_WAIT_V
#undef PG8_WAIT_L
#undef PG8_BAR
#undef PG8_SCHED
}
}
namespace pg8 {
constexpr float C2F = 0.125f * 1.4426950408889634f;
constexpr float W8_SCALE = 512.0f, A8_SCALE = 8.0f, ACC8_INV = 1.0f / 4096.0f;
__device__ __forceinline__ unsigned pk4_fp8(float a, float b, float c, float d) {
    a = __builtin_amdgcn_fmed3f(a, -448.f, 448.f); b = __builtin_amdgcn_fmed3f(b, -448.f, 448.f); c = __builtin_amdgcn_fmed3f(c, -448.f, 448.f); d = __builtin_amdgcn_fmed3f(d, -448.f, 448.f);
    int w = 0; w = __builtin_amdgcn_cvt_pk_fp8_f32(a, b, w, false); w = __builtin_amdgcn_cvt_pk_fp8_f32(c, d, w, true); return (unsigned)w; }

typedef short pg8_v2s __attribute__((ext_vector_type(2)));
__device__ __forceinline__ unsigned pk4_fp8_w(float a, float b, float c, float d) {
    constexpr float LIM = 448.0f / W8_SCALE;
    a = __builtin_amdgcn_fmed3f(a, -LIM, LIM); b = __builtin_amdgcn_fmed3f(b, -LIM, LIM); c = __builtin_amdgcn_fmed3f(c, -LIM, LIM); d = __builtin_amdgcn_fmed3f(d, -LIM, LIM);
    pg8_v2s w = {0, 0}; w = __builtin_amdgcn_cvt_scalef32_pk_fp8_f32(w, a, b, 1.0f / W8_SCALE, false); w = __builtin_amdgcn_cvt_scalef32_pk_fp8_f32(w, c, d, 1.0f / W8_SCALE, true);
    return __builtin_bit_cast(unsigned, w); }

struct EpiProj {
    static constexpr bool PERM = true, AFTER_DRAIN = false;
    bf16_t* P; float* DT; float asc;
    __device__ __forceinline__ void operator()(const f32x4 (&acc)[2][2][4][2], const Unit& u, int wr, int wc, int fr_in, int fq_in) const {
        (void)fr_in; (void)fq_in; const int ln_ = (int)__builtin_amdgcn_mbcnt_hi(~0u, __builtin_amdgcn_mbcnt_lo(~0u, 0u)); int fr = ln_ & 15, fq = ln_ >> 4; asm volatile("" : "+v"(fr), "+v"(fq));
        const int row0 = u.pm * BM + wr * 64 + fr;
        if (u.pn == 22) {
            if (wc == 0 && fq < 2) {
#pragma unroll
                for (int ai = 0; ai < 2; ++ai)
#pragma unroll
                    for (int m = 0; m < 4; ++m) { float* p = DT + (size_t)(row0 + ai * HALF + m * 16) * 16 + 8 * fq;
                        *(f32x4*)p = acc[ai][0][m][0] * asc; *(f32x4*)(p + 4) = acc[ai][0][m][1] * asc; }
            }
            return;
        }
        const float sc = (u.pn == 10 || u.pn == 11 || u.pn == 16 || u.pn == 17) ? C2F * asc : asc;
        const int col0 = u.pn * BM + wc * 32 + 8 * fq;
#pragma unroll
        for (int ai = 0; ai < 2; ++ai)
#pragma unroll
            for (int m = 0; m < 4; ++m) { bf16_t* rowp = P + (size_t)(row0 + ai * HALF + m * 16) * 5632 + col0;
#pragma unroll
                for (int bj = 0; bj < 2; ++bj) { const f32x4 v0 = acc[ai][bj][m][0] * sc, v1 = acc[ai][bj][m][1] * sc;
                    u32x4 w; w.x = cvt_pk_bf16(v0[0], v0[1]); w.y = cvt_pk_bf16(v0[2], v0[3]); w.z = cvt_pk_bf16(v1[0], v1[1]); w.w = cvt_pk_bf16(v1[2], v1[3]);
                    *(u32x4*)(rowp + bj * HALF) = w; } }
    }
};
template <bool BASE16, bool NEXT8 = false> struct EpiResid {
    static constexpr bool PERM = true, AFTER_DRAIN = false;
    const void* base; bf16_t* out; const float* gate; float sc;
    unsigned char* U8; const float* gn; const float* scn; float* rowp; __attribute__((address_space(3))) float* red;
    __device__ __forceinline__ void operator()(const f32x4 (&acc)[2][2][4][2], const Unit& u, int wr, int wc, int fr_in, int fq_in) const {
        (void)fr_in; (void)fq_in; const int ln_ = (int)__builtin_amdgcn_mbcnt_hi(~0u, __builtin_amdgcn_mbcnt_lo(~0u, 0u)); int fr = ln_ & 15, fq = ln_ >> 4; asm volatile("" : "+v"(fr), "+v"(fq));
        const int row0 = u.pm * BM + wr * 64 + fr, col0 = u.pn * BM + wc * 32 + 8 * fq;
        f32x4 gv[2][2], gs[2][2];
#pragma unroll
        for (int bj = 0; bj < 2; ++bj)
#pragma unroll
            for (int n = 0; n < 2; ++n) { gv[bj][n] = *(const f32x4*)(gate + col0 + bj * HALF + n * 4) * sc;
                if (NEXT8) gs[bj][n] = *(const f32x4*)(gn + col0 + bj * HALF + n * 4) * (*(const f32x4*)(scn + col0 + bj * HALF + n * 4) + 1.0f) * A8_SCALE; }
#pragma unroll
        for (int ai = 0; ai < 2; ++ai) {
            u32x4 rb[4][2]; f32x4 fb[4][2][2];
#pragma unroll
            for (int m = 0; m < 4; ++m) { const size_t off = (size_t)(row0 + ai * HALF + m * 16) * 2048 + col0;
#pragma unroll
                for (int bj = 0; bj < 2; ++bj) {
                    if (BASE16) rb[m][bj] = *(const u32x4*)((const bf16_t*)base + off + bj * HALF);
                    else { fb[m][bj][0] = *(const f32x4*)((const float*)base + off + bj * HALF); fb[m][bj][1] = *(const f32x4*)((const float*)base + off + bj * HALF + 4); } } }
#pragma unroll
            for (int m = 0; m < 4; ++m) { const size_t off = (size_t)(row0 + ai * HALF + m * 16) * 2048 + col0; float ss = 0.f;
#pragma unroll
                for (int bj = 0; bj < 2; ++bj) { f32x4 b0, b1;
                    if (BASE16) { const u32x4 r = rb[m][bj];
                        b0 = (f32x4){__uint_as_float(r.x << 16), __uint_as_float(r.x & 0xffff0000u), __uint_as_float(r.y << 16), __uint_as_float(r.y & 0xffff0000u)};
                        b1 = (f32x4){__uint_as_float(r.z << 16), __uint_as_float(r.z & 0xffff0000u), __uint_as_float(r.w << 16), __uint_as_float(r.w & 0xffff0000u)}; }
                    else { b0 = fb[m][bj][0]; b1 = fb[m][bj][1]; }
                    const f32x4 o0 = b0 + gv[bj][0] * acc[ai][bj][m][0], o1 = b1 + gv[bj][1] * acc[ai][bj][m][1];
                    u32x4 w; w.x = cvt_pk_bf16(o0[0], o0[1]); w.y = cvt_pk_bf16(o0[2], o0[3]); w.z = cvt_pk_bf16(o1[0], o1[1]); w.w = cvt_pk_bf16(o1[2], o1[3]);
                    *(u32x4*)(out + off + bj * HALF) = w;
                    if (NEXT8) { typedef unsigned u32x2 __attribute__((ext_vector_type(2)));
                        ss += (o0[0] * o0[0] + o0[1] * o0[1]) + (o0[2] * o0[2] + o0[3] * o0[3]) + (o1[0] * o1[0] + o1[1] * o1[1]) + (o1[2] * o1[2] + o1[3] * o1[3]);
                        const f32x4 q0 = o0 * gs[bj][0], q1 = o1 * gs[bj][1]; u32x2 q; q.x = pk4_fp8(q0[0], q0[1], q0[2], q0[3]); q.y = pk4_fp8(q1[0], q1[1], q1[2], q1[3]);
                        *(u32x2*)(U8 + off + bj * HALF) = q; } }
                if (NEXT8) { ss += __shfl_xor(ss, 16); ss += __shfl_xor(ss, 32);
                    if (fq == 0) red[wc * 256 + wr * 64 + fr + ai * HALF + m * 16] = ss; } }
            asm volatile("" ::: "memory"); }
        if (NEXT8) { __syncthreads();
            int t = (int)threadIdx.x; asm volatile("" : "+v"(t));
            if (t < 256) rowp[(size_t)(u.pm * BM + t) * 8 + u.pn] = (red[t] + red[256 + t]) + (red[512 + t] + red[768 + t]); }
    }
};
__device__ __forceinline__ float silu_mul(float a, float b) { return a * b * __builtin_amdgcn_rcpf(1.0f + __builtin_amdgcn_exp2f(-1.4426950408889634f * a)); }
template <int TPE, int LDC, bool NORM = false> struct EpiSwiGLU {
    static constexpr bool PERM = true, AFTER_DRAIN = false;
    unsigned char* O; const float* rowp; const float* bias;
    __device__ __forceinline__ void operator()(const f32x4 (&acc)[2][2][4][2], const Unit& u, int wr, int wc, int fr_in, int fq_in) const {
        (void)fr_in; (void)fq_in; const int ln_ = (int)__builtin_amdgcn_mbcnt_hi(~0u, __builtin_amdgcn_mbcnt_lo(~0u, 0u)); int fr = ln_ & 15, fq = ln_ >> 4; asm volatile("" : "+v"(fr), "+v"(fq));
        const int row0 = u.po * BM + wr * 64 + fr, pl = u.pn % TPE, col0 = pl * HALF + wc * 32 + 8 * fq;
        typedef unsigned u32x2 __attribute__((ext_vector_type(2)));
        f32x4 ba[2], bb[2];
        if (NORM) { const float* bp = bias + u.pn * BM + wc * 32 + 8 * fq; ba[0] = *(const f32x4*)bp; ba[1] = *(const f32x4*)(bp + 4); bb[0] = *(const f32x4*)(bp + HALF); bb[1] = *(const f32x4*)(bp + HALF + 4); }
#pragma unroll
        for (int ai = 0; ai < 2; ++ai) {
            float rsv[4];
            if (NORM) { f32x4 pa[4], pb[4];
#pragma unroll
                for (int m = 0; m < 4; ++m) { const float* rp = rowp + (size_t)(u.pm * BM + wr * 64 + fr + ai * HALF + m * 16) * 8; pa[m] = *(const f32x4*)rp; pb[m] = *(const f32x4*)(rp + 4); }
#pragma unroll
                for (int m = 0; m < 4; ++m) rsv[m] = ACC8_INV * __builtin_amdgcn_rsqf((((pa[m][0] + pa[m][1]) + (pa[m][2] + pa[m][3])) + ((pb[m][0] + pb[m][1]) + (pb[m][2] + pb[m][3]))) * (1.0f / 2048.0f) + 1e-6f); }
#pragma unroll
            for (int m = 0; m < 4; ++m) { unsigned char* orow = O + (size_t)(row0 + ai * HALF + m * 16) * LDC + col0;
                const float rs = NORM ? rsv[m] : ACC8_INV;
                u32x2 w;
                { f32x4 a0 = acc[ai][0][m][0] * rs, b0 = acc[ai][1][m][0] * rs; if (NORM) { a0 += ba[0]; b0 += bb[0]; } b0 *= A8_SCALE;
                  w.x = pk4_fp8(silu_mul(a0[0], b0[0]), silu_mul(a0[1], b0[1]), silu_mul(a0[2], b0[2]), silu_mul(a0[3], b0[3])); }
                asm volatile("" : "+v"(w.x));
                { f32x4 a1 = acc[ai][0][m][1] * rs, b1 = acc[ai][1][m][1] * rs; if (NORM) { a1 += ba[1]; b1 += bb[1]; } b1 *= A8_SCALE;
                  w.y = pk4_fp8(silu_mul(a1[0], b1[0]), silu_mul(a1[1], b1[1]), silu_mul(a1[2], b1[2]), silu_mul(a1[3], b1[3])); }
                *(u32x2*)orow = w; asm volatile("" ::: "memory"); } }
    }
};
template <int TPE, int LDC> struct EpiPlain {
    static constexpr bool PERM = true, AFTER_DRAIN = false;
    bf16_t* O;
    __device__ __forceinline__ void operator()(const f32x4 (&acc)[2][2][4][2], const Unit& u, int wr, int wc, int fr_in, int fq_in) const {
        (void)fr_in; (void)fq_in; const int ln_ = (int)__builtin_amdgcn_mbcnt_hi(~0u, __builtin_amdgcn_mbcnt_lo(~0u, 0u)); int fr = ln_ & 15, fq = ln_ >> 4; asm volatile("" : "+v"(fr), "+v"(fq));
        const int row0 = u.pm * BM + wr * 64 + fr, pl = u.pn % TPE, col0 = pl * BM + wc * 32 + 8 * fq;
#pragma unroll
        for (int ai = 0; ai < 2; ++ai)
#pragma unroll
            for (int m = 0; m < 4; ++m) { bf16_t* rowp = O + (size_t)(row0 + ai * HALF + m * 16) * LDC + col0;
#pragma unroll
                for (int bj = 0; bj < 2; ++bj) { const f32x4 v0 = acc[ai][bj][m][0] * ACC8_INV, v1 = acc[ai][bj][m][1] * ACC8_INV;
                    u32x4 w; w.x = cvt_pk_bf16(v0[0], v0[1]); w.y = cvt_pk_bf16(v0[2], v0[3]); w.z = cvt_pk_bf16(v1[0], v1[1]); w.w = cvt_pk_bf16(v1[2], v1[3]);
                    *(u32x4*)(rowp + bj * HALF) = w; } }
    }
};
struct EpiTail {
    static constexpr bool PERM = true, AFTER_DRAIN = false;
    bf16_t* T;
    __device__ __forceinline__ void operator()(const f32x4 (&acc)[2][2][4][2], const Unit& u, int wr, int wc, int fr_in, int fq_in) const {
        (void)fr_in; (void)fq_in; const int ln_ = (int)__builtin_amdgcn_mbcnt_hi(~0u, __builtin_amdgcn_mbcnt_lo(~0u, 0u)); int fr = ln_ & 15, fq = ln_ >> 4; asm volatile("" : "+v"(fr), "+v"(fq));
        bf16_t* base = T + (size_t)u.po * 65536 + (size_t)(wr * 64 + fr) * 256 + wc * 32 + 8 * fq;
#pragma unroll
        for (int ai = 0; ai < 2; ++ai)
#pragma unroll
            for (int m = 0; m < 4; ++m) { bf16_t* rowp = base + (size_t)(ai * HALF + m * 16) * 256;
#pragma unroll
                for (int bj = 0; bj < 2; ++bj) { const f32x4 v0 = acc[ai][bj][m][0] * ACC8_INV, v1 = acc[ai][bj][m][1] * ACC8_INV;
                    u32x4 w; w.x = cvt_pk_bf16(v0[0], v0[1]); w.y = cvt_pk_bf16(v0[2], v0[3]); w.z = cvt_pk_bf16(v1[0], v1[1]); w.w = cvt_pk_bf16(v1[2], v1[3]);
                    *(u32x4*)(rowp + bj * HALF) = w; } }
    }
};
__device__ __forceinline__ void moe_unit_map(const PG8_LAS int* tab, int tpe, int L, int& pm, int& e_out, int& j_out) {
    const int nwg = tab[8] * tpe;
    int wgid = L; { const int q = nwg / NXCD, r = nwg % NXCD, xcd = wgid % NXCD, off = wgid / NXCD; wgid = (xcd < r ? xcd * (q + 1) : r * (q + 1) + (xcd - r) * q) + off; }
    int e = 0;
#pragma unroll
    for (int k = 1; k < 8; ++k) e += (wgid >= tab[k] * tpe) ? 1 : 0;
    const int f = tab[e], nt = tab[e + 1] - f, idx = wgid - f * tpe;
    pm = f + idx % nt; e_out = e; j_out = idx / nt;
}
struct GroupedOrder {
    static __device__ __forceinline__ void build_full(PG8_LAS int* list, const PG8_LAS int* tab, int tpe, int lfull, int G, int c, int i) {
        const int nwg = tab[8] * tpe, lim = nwg < lfull ? nwg : lfull; const int L = i * G + c; int pm = -1, pn = 0;
        if (L < lim) { int e, j; moe_unit_map(tab, tpe, L, pm, e, j); pn = e * tpe + j; }
        list[4 * i] = pm; list[4 * i + 1] = pn; list[4 * i + 2] = 0; list[4 * i + 3] = pm;
    }
    static __device__ __forceinline__ void build_tail(PG8_LAS int* list, const PG8_LAS int* tab, int tpe, int lfull, int kparts, int kob, int G, int c, int i) {
        const int nwg = tab[8] * tpe, ntail = nwg > lfull ? nwg - lfull : 0; const int S = i * G + c; int pm = -1, pn = 0, ko = 0, po = 0;
        if (S < ntail * kparts) { const int q = S % ntail, kp = S / ntail; int e, j; moe_unit_map(tab, tpe, lfull + q, pm, e, j); pn = e * tpe + j; ko = kp * kob; po = kp * 64 + q; }
        list[4 * i] = pm; list[4 * i + 1] = pn; list[4 * i + 2] = ko; list[4 * i + 3] = po;
    }
    const PG8_LAS int* list;
    static __device__ __forceinline__ void build(PG8_LAS int* list, const PG8_LAS int* tab, int tpe, int ksp, int kob, int abase, int G, int c, int i) {
        const int tpf = tpe * ksp, nwg = tab[8] * tpf; const long L = (long)i * G + c; int pm = -1, pn = 0, ko = 0, po = 0;
        if (L < nwg) {
            int wgid = (int)L; { const int q = nwg / NXCD, r = nwg % NXCD, xcd = wgid % NXCD, off = wgid / NXCD; wgid = (xcd < r ? xcd * (q + 1) : r * (q + 1) + (xcd - r) * q) + off; }
            int e = 0;
#pragma unroll
            for (int k = 1; k < 8; ++k) e += (wgid >= tab[k] * tpf) ? 1 : 0;
            const int f = tab[e], nt = tab[e + 1] - f, idx = wgid - f * tpf, rest = idx / nt, loc = idx % nt;
            po = f + loc; pm = abase ? e * abase + loc : po; pn = e * tpe + rest % tpe; ko = (rest / tpe) * kob; }
        list[4 * i] = pm; list[4 * i + 1] = pn; list[4 * i + 2] = ko; list[4 * i + 3] = po;
    }
    __device__ __forceinline__ bool next(int i, Unit& u) const {
        if (i >= 32) return false;
        const int pm = __builtin_amdgcn_readfirstlane(list[4 * i]); if (pm < 0) return false;
        u.pm = pm; u.pn = __builtin_amdgcn_readfirstlane(list[4 * i + 1]); u.ko = __builtin_amdgcn_readfirstlane(list[4 * i + 2]); u.po = __builtin_amdgcn_readfirstlane(list[4 * i + 3]); return true;
    }
    __device__ __forceinline__ void a_ready(const Unit&) const {}
    __device__ __forceinline__ void done(const Unit&) const {}
};
}
constexpr int NTOK = 8192, DM = 2048, NMOD = 12288, NPROJ = 5632, NPROJ_T = 5888, NIN = 5648;
constexpr int FFD = 5632, FFE = 7168, NEXP = 8, MAXROWS = 18432;
constexpr int C_Z = 0, C_XBC = 1024, C_MQ = 2560, C_MK = 3072, C_MV = 3584, C_DQ = 4096, C_DK = 4608, C_DV = 5120;
constexpr float EPSF = 1e-6f, LOG2E = 1.4426950408889634f;
constexpr size_t MiB = 1u << 20;
constexpr size_t WS_CTL = 0, CTL_ZERO_BYTES = 1 * MiB;
constexpr size_t WS_MODP = 1 * MiB, WS_MOD = 2 * MiB, WS_KM = 6 * MiB, WS_ROUTE = 3 * MiB + 256 * 1024, WS_DT = 4 * MiB, WS_DTV = 4 * MiB + 512 * 1024, WS_ACS = 5 * MiB;
constexpr size_t WS_BIASU = 7 * MiB, WS_ROWP = 7 * MiB + 256 * 1024;
constexpr size_t WS_WIN = 8 * MiB, WS_WOUT = 56 * MiB, WS_W13 = 72 * MiB, WS_W2 = 116 * MiB, WS_W13E = 138 * MiB, WS_W2E = 586 * MiB;
constexpr size_t WS_H = 810 * MiB, WS_PROJ = 842 * MiB, WS_XC = 930 * MiB, WS_YRAW = 954 * MiB, WS_MOBA = 986 * MiB, WS_DIFF = 994 * MiB, WS_Y = 1010 * MiB, WS_XA = 1042 * MiB;
constexpr size_t WS_XG8S = (138 + 224) * MiB;
constexpr size_t WS_YG2 = (1106 + 128) * MiB;
constexpr size_t WS_G = 1106 * MiB, WS_XG = 1358 * MiB, WS_YG = 1430 * MiB, WS_SST = 1502 * MiB, WS_HPREV = 1518 * MiB, WS_END = 1534 * MiB;
static_assert(WS_WIN + 2ull * NPROJ_T * DM * 2 <= WS_WOUT && WS_WOUT + 2ull * DM * DM * 2 <= WS_W13 && WS_W13 + 2ull * FFD * DM * 2 <= WS_W2 && WS_W2 + (size_t)DM * FFD * 2 <= WS_W13E, "ws map 1");
static_assert(WS_W13E + 8ull * 2 * FFE * DM * 2 <= WS_W2E && WS_W2E + 8ull * DM * FFE * 2 <= WS_H && WS_PROJ + (size_t)NTOK * NPROJ * 2 <= WS_XC && WS_G + (size_t)MAXROWS * FFE * 2 <= WS_XG, "ws map 2");
static_assert(WS_XG + (size_t)MAXROWS * DM * 2 <= WS_YG && WS_YG + (size_t)MAXROWS * DM * 2 <= WS_SST, "ws map 3");
constexpr int CW_TMO = 0, CW_CODE = 1, CW_CNT = 64, CW_Q = 128, CW_BAR = 4096;
constexpr int RING_OFF = 0, RING_BYTES = 131072, LDSCTL_OFF = 139264, LDS_BYTES = 147456;
constexpr int NWAVES = 8, NPHASE = 25;

#define GAS __attribute__((address_space(1)))
#define LAS __attribute__((address_space(3)))
typedef unsigned short bf16;
typedef unsigned v4u __attribute__((ext_vector_type(4)));
typedef unsigned v2u __attribute__((ext_vector_type(2)));
typedef float f32x4 __attribute__((ext_vector_type(4)));
#define RLX_AGENT __ATOMIC_RELAXED, __HIP_MEMORY_SCOPE_AGENT
#define LDS_WAIT() asm volatile("s_waitcnt lgkmcnt(0)" ::: "memory")
__device__ __forceinline__ unsigned f2bf(float f) { unsigned u = __builtin_bit_cast(unsigned, f); return (u + 0x7fffu + ((u >> 16) & 1u)) >> 16; }
__device__ __forceinline__ unsigned pk2(float lo, float hi) { return f2bf(lo) | (f2bf(hi) << 16); }
__device__ __forceinline__ float bflo(unsigned w) { return __uint_as_float(w << 16); }
__device__ __forceinline__ float bfhi(unsigned w) { return __uint_as_float(w & 0xffff0000u); }
__device__ __forceinline__ float bf1(bf16 b) { return __uint_as_float((unsigned)b << 16); }
__device__ __forceinline__ float wave_sum(float v) {
#pragma unroll
    for (int o = 1; o < 64; o <<= 1) v += __shfl_xor(v, o);
    return v;
}
__device__ __forceinline__ float wave_max(float v) {
#pragma unroll
    for (int o = 1; o < 64; o <<= 1) v = fmaxf(v, __shfl_xor(v, o));
    return v;
}
__device__ __forceinline__ float siluf(float a) { return a / (1.0f + __expf(-a)); }
#define XB_TMO      128
#define XB_XCNT(j)  (256  + 64 * (j))
#define XB_XSUB(j)  (1280 + 64 * (j))
#define XB_XGEN(j)  (2304 + 64 * (j))
#define XB_TOP      3328
#define XB_TOPGEN   3392
#define XCD_BAR_WORDS 3456
#define XB_SPIN_CAP (1u << 22)

__device__ __forceinline__ unsigned xb_ld(unsigned* p)              { return __hip_atomic_load(p, __ATOMIC_RELAXED, __HIP_MEMORY_SCOPE_AGENT); }
__device__ __forceinline__ unsigned xb_add(unsigned* p, unsigned v) { return __hip_atomic_fetch_add(p, v, __ATOMIC_RELAXED, __HIP_MEMORY_SCOPE_AGENT); }
__device__ __forceinline__ unsigned xb_xcc_id() { return (unsigned)__builtin_amdgcn_s_getreg((3 << 11) | 20) & 0xFu; }
#define XB_SPIN(cond, bar) do { unsigned _sp = 0; while (cond) { __builtin_amdgcn_s_sleep(1); \
    if ((++_sp & 255u) == 0u) { if (xb_ld(&(bar)[XB_TMO])) break; if (_sp > XB_SPIN_CAP) { atomicAdd(&(bar)[XB_TMO], 1u); break; } } } } while (0)

struct XcdBarrier {
    unsigned* bar; unsigned x;
    volatile LAS unsigned* st;
};

__device__ __forceinline__ XcdBarrier xcd_barrier_post(unsigned* bar, volatile LAS unsigned* st) {
    XcdBarrier b; b.bar = bar; b.x = xb_xcc_id(); b.st = st;
    if (threadIdx.x == 0) (void)xb_add(&bar[XB_XCNT(b.x)], 1u);
    return b;
}
__device__ __forceinline__ void xcd_barrier_complete(unsigned* bar, unsigned x, unsigned& nloc, unsigned& nx) {
    const unsigned G = gridDim.x * gridDim.y * gridDim.z;
    unsigned sum, cnt, mine, sp = 0u;
    for (;;) {
        sum = 0u; cnt = 0u; mine = 0u;
#pragma unroll
        for (unsigned j = 0; j < 16; ++j) { const unsigned c = xb_ld(&bar[XB_XCNT(j)]); sum += c; cnt += (c > 0u) ? 1u : 0u; mine = (j == x) ? c : mine; }
        if (sum == G) break;
        __builtin_amdgcn_s_sleep(1);
        if ((++sp & 255u) == 0u) { if (xb_ld(&bar[XB_TMO])) break; if (sp > XB_SPIN_CAP) { atomicAdd(&bar[XB_TMO], 1u); break; } }
    }
    nloc = mine > 0u ? mine : 1u; nx = cnt > 0u ? cnt : 1u;
}

__device__ __forceinline__ void xcd_barrier(const XcdBarrier& b) {
    asm volatile("s_waitcnt vmcnt(0)" ::: "memory");
    __syncthreads();
    if (threadIdx.x == 0) {
        unsigned* bar = b.bar;
        __builtin_amdgcn_s_waitcnt(0);
        unsigned nloc = b.st[0], nx = b.st[1];
        if (nloc == 0u) { xcd_barrier_complete(bar, b.x, nloc, nx); b.st[0] = nloc; b.st[1] = nx; }
        const unsigned old = xb_add(&bar[XB_XSUB(b.x)], 1u);
        const unsigned gen = old / nloc;
        if (old + 1u == (gen + 1u) * nloc) {
            __builtin_amdgcn_fence(__ATOMIC_RELEASE, "agent");
            asm volatile("s_waitcnt vmcnt(0)" ::: "memory");
            const unsigned og = xb_add(&bar[XB_TOP], 1u);
            const unsigned tg = og / nx;
            if (og + 1u == (tg + 1u) * nx) xb_add(&bar[XB_TOPGEN], 1u);
            else XB_SPIN(xb_ld(&bar[XB_TOPGEN]) == tg, bar);
            __builtin_amdgcn_fence(__ATOMIC_ACQUIRE, "agent");
            xb_add(&bar[XB_XGEN(b.x)], 1u);
            asm volatile("s_waitcnt vmcnt(0)" ::: "memory");
        } else {
            XB_SPIN(xb_ld(&bar[XB_XGEN(b.x)]) == gen, bar);
            __builtin_amdgcn_fence(__ATOMIC_ACQUIRE, "agent");
            asm volatile("s_waitcnt vmcnt(0)" ::: "memory");
        }
    }
    __syncthreads();
}
#include <hip/hip_bf16.h>
#include <cmath>
namespace attn_body {
using bf16=__hip_bfloat16;
typedef float f32x4a __attribute__((ext_vector_type(4))); typedef int i32x4a __attribute__((ext_vector_type(4)));
using bf16x8=__attribute__((ext_vector_type(8)))short;
using s16x4=__attribute__((ext_vector_type(4)))short;
using f32x16=__attribute__((ext_vector_type(16)))float;
using u32x4=__attribute__((ext_vector_type(4)))unsigned;
constexpr int SEQ=8192,D=64,DM=5632;
constexpr int NW=8,QBLK=32,QB=QBLK*NW,KVBLK=64,NQB=SEQ/QB;
__device__ __forceinline__ int crow(int r,int hi){return (r&3)+8*(r>>2)+4*hi;}
#define SBAR() __builtin_amdgcn_sched_barrier(0)
__device__ __forceinline__ void cmask(f32x16&p0,f32x16&p1,int jb,int qrel,int hi){
  const float NEG=-INFINITY; int kb=64*jb+4*hi;
  #pragma unroll
  for(int r=0;r<16;++r){int kv=kb+(r&3)+8*(r>>2); if(kv>qrel)p0[r]=NEG; if(kv+32>qrel)p1[r]=NEG;}
}

constexpr int NSLOT=3, SLOTB=8192;
constexpr int LDS_K=0, LDS_V=NSLOT*SLOTB, LDS_WS=2*NSLOT*SLOTB, LDS_OST=LDS_WS+NW*64*4, LDS_BYTES=LDS_OST+NW*4096;
constexpr float C2=0.125f*1.4426950408889634f;
__device__ __forceinline__ void glds16(const void*gsrc,unsigned lds_dst){unsigned keep;
  asm volatile("s_mov_b32 %0, m0\n\ts_mov_b32 m0, %2\n\ts_nop 0\n\tglobal_load_lds_dwordx4 %1, off\n\ts_mov_b32 m0, %0":"=&s"(keep):"v"(gsrc),"s"(lds_dst):"memory");}
__device__ __forceinline__ float max3f(float a,float b,float c){float r;asm("v_max3_f32 %0, %1, %2, %3":"=v"(r):"v"(a),"v"(b),"v"(c));return r;}
__device__ __forceinline__ float max2f(float a,float b){float r;asm("v_max_f32_e32 %0, %1, %2":"=v"(r):"v"(a),"v"(b));return r;}
__device__ __forceinline__ float fadd_s(float a,float b){float r;asm("v_add_f32_e32 %0, %1, %2":"=v"(r):"v"(a),"v"(b));return r;}
__device__ __forceinline__ float fsub_s(float a,float b){float r;asm("v_sub_f32_e32 %0, %1, %2":"=v"(r):"v"(a),"v"(b));return r;}
typedef float f32x2_t __attribute__((ext_vector_type(2))); typedef __bf16 bf16x2_t __attribute__((ext_vector_type(2)));
__device__ __forceinline__ unsigned cvtpk_s(float lo,float hi){f32x2_t v={lo,hi};bf16x2_t b=__builtin_convertvector(v,bf16x2_t);return __builtin_bit_cast(unsigned,b);}
#define WAIT_BAR(N) asm volatile("s_waitcnt vmcnt(" #N ") lgkmcnt(0)\n\ts_barrier":::"memory")

__device__ __forceinline__ void qkt(f32x16&p0,f32x16&p1,const char*Kslot,const bf16x8*qr,const f32x16&negm,int r32,int hi){
  const char*kb=Kslot+hi*1024+r32*16;
  #pragma unroll
  for(int d0=0;d0<4;++d0){
    const bf16x8 b0=*reinterpret_cast<const bf16x8*>(kb+d0*2048);
    const bf16x8 b1=*reinterpret_cast<const bf16x8*>(kb+d0*2048+512);
    if(d0==0){p0=__builtin_amdgcn_mfma_f32_32x32x16_bf16(b0,qr[0],negm,0,0,0);p1=__builtin_amdgcn_mfma_f32_32x32x16_bf16(b1,qr[0],negm,0,0,0);}
    else{p0=__builtin_amdgcn_mfma_f32_32x32x16_bf16(b0,qr[d0],p0,0,0,0);p1=__builtin_amdgcn_mfma_f32_32x32x16_bf16(b1,qr[d0],p1,0,0,0);}}
}
typedef __attribute__((address_space(3))) const char* lds_cptr;
typedef short v4i16_t __attribute__((ext_vector_type(4)));
__device__ __forceinline__ void kload8(bf16x8*kf,lds_cptr kp){
  kf[0]=*(const __attribute__((address_space(3))) bf16x8*)(kp);      kf[1]=*(const __attribute__((address_space(3))) bf16x8*)(kp+512);
  kf[2]=*(const __attribute__((address_space(3))) bf16x8*)(kp+2048); kf[3]=*(const __attribute__((address_space(3))) bf16x8*)(kp+2560);
  kf[4]=*(const __attribute__((address_space(3))) bf16x8*)(kp+4096); kf[5]=*(const __attribute__((address_space(3))) bf16x8*)(kp+4608);
  kf[6]=*(const __attribute__((address_space(3))) bf16x8*)(kp+6144); kf[7]=*(const __attribute__((address_space(3))) bf16x8*)(kp+6656);
}
__device__ __forceinline__ void kload2(bf16x8*kf,lds_cptr kp,int j){ kf[2*j]=*(const __attribute__((address_space(3))) bf16x8*)(kp+j*2048); kf[2*j+1]=*(const __attribute__((address_space(3))) bf16x8*)(kp+j*2048+512); }
__device__ __forceinline__ s16x4 vtr(lds_cptr p){ return __builtin_bit_cast(s16x4,__builtin_amdgcn_ds_read_tr16_b64_v4i16((__attribute__((address_space(3))) v4i16_t*)p)); }
__device__ __forceinline__ float rowmax(const f32x16&p0,const f32x16&p1){
  float a=max3f(p0[0],p0[1],p1[0]),b=max3f(p0[2],p0[3],p1[1]);a=max3f(a,p1[2],p1[3]);
  #pragma unroll
  for(int r=4;r<16;r+=4){a=max3f(a,p0[r],p0[r+1]);b=max3f(b,p0[r+2],p0[r+3]);a=max3f(a,p1[r],p1[r+1]);b=max3f(b,p1[r+2],p1[r+3]);}
  const float m=max2f(a,b);
  auto rr=__builtin_amdgcn_permlane32_swap(__float_as_uint(m),__float_as_uint(m),false,false);
  return max2f(__uint_as_float(rr[0]),__uint_as_float(rr[1]));
}
__device__ __forceinline__ void pv(f32x16*o,int vb,bf16x8 pa0,bf16x8 pa1,bf16x8 pa2,bf16x8 pa3){
  #pragma unroll
  for(int d0=0;d0<2;++d0){s16x4 lo[4],hi[4];
    #pragma unroll
    for(int ks=0;ks<4;++ks){
      asm volatile("ds_read_b64_tr_b16 %0,%1 offset:%c2":"=&v"(lo[ks]):"v"(vb),"i"(d0*4096+ks*1024):"memory");
      asm volatile("ds_read_b64_tr_b16 %0,%1 offset:%c2":"=&v"(hi[ks]):"v"(vb),"i"(d0*4096+ks*1024+512):"memory");}
    asm volatile("s_waitcnt lgkmcnt(0)":::"memory");SBAR();
    #define PK(k) (bf16x8){lo[k][0],lo[k][1],lo[k][2],lo[k][3],hi[k][0],hi[k][1],hi[k][2],hi[k][3]}
    o[d0]=__builtin_amdgcn_mfma_f32_32x32x16_bf16(pa0,PK(0),o[d0],0,0,0);
    o[d0]=__builtin_amdgcn_mfma_f32_32x32x16_bf16(pa1,PK(1),o[d0],0,0,0);
    o[d0]=__builtin_amdgcn_mfma_f32_32x32x16_bf16(pa2,PK(2),o[d0],0,0,0);
    o[d0]=__builtin_amdgcn_mfma_f32_32x32x16_bf16(pa3,PK(3),o[d0],0,0,0);
    #undef PK
  }
}

#ifndef ATTN_STORE16
#define ATTN_STORE16(p,v) (*(u32x4*)(p)=(v))
#endif
template<int THRL,int MODE> __device__ __forceinline__ void attn_unit(int qb,const bf16*Qh,const bf16*__restrict__ Kh,const bf16*__restrict__ Vh,bf16*Oh,int opitch,char*shm,
    const __attribute__((address_space(3))) int*posL,const __attribute__((address_space(3))) int*kmaxL,const __attribute__((address_space(3))) float*biasH,const __attribute__((address_space(3))) float*kmL){
  int tid_=threadIdx.x; asm volatile("":"+v"(tid_));
  const int tid=tid_,lane=tid&63,r32=lane&31,hi=lane>>5; const int wid=__builtin_amdgcn_readfirstlane(tid>>6);
  const int q0=qb*QB;
  const bf16*Qw=Qh+(long)(q0+wid*QBLK)*DM;
  const unsigned lds0=(unsigned)(uintptr_t)shm;
  float*wsf=(float*)(shm+LDS_WS)+wid*64;
  const bf16*ksrc=Kh+(long)lane*DM+wid*8;
  const bf16*vsrc=Vh+(long)(16*(wid&3)+(lane>>2))*DM+(wid>>2)*32+(lane&3)*8;
  const unsigned kdst=lds0+LDS_K+wid*1024, vdst=lds0+LDS_V+wid*1024;
  #define DMA_K(t,slot) glds16(ksrc+(long)(t)*KVBLK*DM,(unsigned)__builtin_amdgcn_readfirstlane(kdst+(slot)))
  #define DMA_V(t,slot) glds16(vsrc+(long)(t)*KVBLK*DM,(unsigned)__builtin_amdgcn_readfirstlane(vdst+(slot)))
  const int vb0=(int)(lds0+LDS_V)+((lane>>4)&1)*32+(lane&3)*8+(4*hi+((lane&15)>>2))*64;
  const char*Kbase=shm+LDS_K; bf16x8 kf[8];
  const lds_cptr shm3=(lds_cptr)shm; const lds_cptr kp0=shm3+LDS_K+hi*1024+r32*16; const lds_cptr vp0=shm3+LDS_V+((lane>>4)&1)*32+(lane&3)*8+(4*hi+((lane&15)>>2))*64;
  const int NT=(q0+QB)/KVBLK;
  DMA_K(0,0);DMA_V(0,0);DMA_K(1,SLOTB);
  bf16x8 qr[4];
  #pragma unroll
  for(int d0=0;d0<4;++d0)qr[d0]=*reinterpret_cast<const bf16x8*>(&Qw[(long)r32*DM+d0*16+hi*8]);
  const int qrel=wid*QBLK+r32;
  const int qpos=posL[q0+qrel];
  int tnear;
  { int qmn=qpos; _Pragma("unroll") for(int o_=1;o_<64;o_<<=1){ const int x_=__shfl_xor(qmn,o_); qmn=x_<qmn?x_:qmn; }
    const int NT_=(q0+QB)/KVBLK;
    const bool c0_=(lane<NT_)&&(qmn-kmaxL[lane]<128), c1_=(lane+64<NT_)&&(qmn-kmaxL[(lane+64)&127]<128);
    const unsigned long long b0_=__ballot(c0_), b1_=__ballot(c1_);
    const int tn=b0_?(__ffsll((long long)b0_)-1):(b1_?(64+__ffsll((long long)b1_)-1):NT_); tnear=__builtin_amdgcn_readfirstlane(tn); }
  unsigned selmask=0xffffffffu;
  if(MODE==1){ float qf[32];
    _Pragma("unroll") for(int d0=0;d0<4;++d0){ _Pragma("unroll") for(int j=0;j<8;++j) qf[8*d0+j]=__uint_as_float(((unsigned)(unsigned short)qr[d0][j])<<16); }
    float v0=-INFINITY,v1=-INFINITY,v2=-INFINITY; int i0=0,i1=0,i2=0;
    for(int j=0;j<qb;++j){ const __attribute__((address_space(3))) float*kp=kmL+j*64+8*hi; float s_=0.f;
      _Pragma("unroll") for(int d0=0;d0<4;++d0){ const f32x4a a_=*(const __attribute__((address_space(3))) f32x4a*)(kp+16*d0), b_=*(const __attribute__((address_space(3))) f32x4a*)(kp+16*d0+4);
        s_+=qf[8*d0+0]*a_[0]+qf[8*d0+1]*a_[1]+qf[8*d0+2]*a_[2]+qf[8*d0+3]*a_[3]+qf[8*d0+4]*b_[0]+qf[8*d0+5]*b_[1]+qf[8*d0+6]*b_[2]+qf[8*d0+7]*b_[3]; }
      s_+=__shfl_xor(s_,32);
      if(s_>v0){v2=v1;i2=i1;v1=v0;i1=i0;v0=s_;i0=j;} else if(s_>v1){v2=v1;i2=i1;v1=s_;i1=j;} else if(s_>v2){v2=s_;i2=j;} }
    selmask=1u<<qb; if(qb>=1)selmask|=1u<<i0; if(qb>=2)selmask|=1u<<i1; if(qb>=3)selmask|=1u<<i2; }
  float mhat=0.f,l_reg=0.f;f32x16 o[2];o[0]=f32x16{};o[1]=f32x16{};f32x16 negm=f32x16{};asm volatile("":"+v"(negm));
  #define CMASK(P0,P1,t) do{int jb_=(t)-(NT-4); if(jb_>=0)cmask(P0,P1,jb_,qrel,hi);}while(0)
  #define BIAS(P0,P1,t) do{ if((t)>=tnear){ const __attribute__((address_space(3))) int*pp_=posL+64*(t)+4*hi; \
      _Pragma("unroll") for(int g_=0;g_<4;++g_){ const i32x4a ka_=*(const __attribute__((address_space(3))) i32x4a*)(pp_+8*g_), kb_=*(const __attribute__((address_space(3))) i32x4a*)(pp_+8*g_+32); \
        _Pragma("unroll") for(int i_=0;i_<4;++i_){ int da_=qpos-ka_[i_]; da_=da_<0?0:(da_>128?128:da_); int db_=qpos-kb_[i_]; db_=db_<0?0:(db_>128?128:db_); \
          P0[4*g_+i_]+=biasH[da_]; P1[4*g_+i_]+=biasH[db_]; } } } }while(0)
  bool resc=false;
  #define START(P0,P1) do{ const float rm=rowmax(P0,P1); resc=false; \
    { const float dl=rm; mhat=fadd_s(mhat,dl); \
      _Pragma("unroll") for(int r=0;r<16;++r){P0[r]=fsub_s(P0[r],dl);P1[r]=fsub_s(P1[r],dl);} \
      _Pragma("unroll") for(int r=0;r<16;++r)negm[r]=-mhat; asm volatile("":"+v"(negm)); } \
    _Pragma("unroll") for(int r=0;r<16;++r)P0[r]=__builtin_amdgcn_exp2f(P0[r]); }while(0)
  #define RESC() do{ if(resc){ asm volatile("s_waitcnt lgkmcnt(0)":::"memory"); \
      _Pragma("unroll") for(int d_=0;d_<2;++d_) _Pragma("unroll") for(int r=0;r<16;++r)o[d_][r]*=wsf[crow(r,hi)]; } }while(0)
  f32x16 pA0,pA1,pB0,pB1;
  int sl_prev=0,sl_cur=0,sl_next=SLOTB;
  #define ROT() do{sl_prev=sl_cur;sl_cur=sl_next;sl_next=(sl_next==(NSLOT-1)*SLOTB)?0:sl_next+SLOTB;}while(0)
  DMA_K(2,2*SLOTB);
  WAIT_BAR(3);
  qkt(pA0,pA1,Kbase,qr,negm,r32,hi);asm volatile("s_nop 15\n\ts_nop 7":"+v"(pA0),"+v"(pA1));CMASK(pA0,pA1,0);BIAS(pA0,pA1,0);
  START(pA0,pA1);
  _Pragma("unroll") for(int r=0;r<16;++r)pA1[r]=__builtin_amdgcn_exp2f(pA1[r]);
  WAIT_BAR(0);
  DMA_K(3,0);DMA_V(1,SLOTB);
  ROT();
  kload8(kf,kp0+sl_cur);
  WAIT_BAR(2);
  s16x4 vlo[8],vhi[8]; u32x4 pw0,pw1,pw2,pw3;
  #define PKW(P,B) cvtpk_s(P[B],P[B+1])
  #define PAF(k) __builtin_bit_cast(bf16x8,pw##k)
  #define VFR(i) (bf16x8){vlo[i][0],vlo[i][1],vlo[i][2],vlo[i][3],vhi[i][0],vhi[i][1],vhi[i][2],vhi[i][3]}
  #define PIN(x) asm volatile("":"+v"(x))
  #define MX3(a,b,c) __builtin_fmaxf(__builtin_fmaxf((a),(b)),(c))
  #define GAPA(MF,A0,A1,A2,A3,W0,W1,PW) do{ MF; sacc+=A0; sacc+=A1; sacc+=A2; sacc+=A3; PIN(sacc); W0; W1; PIN(PW); SBAR(); }while(0)
  #define EX(v) __builtin_amdgcn_exp2f(v)
  #define GAPB(MF,X,B) do{ MF; X[B]=EX(X[B]); X[B+1]=EX(X[B+1]); X[B+2]=EX(X[B+2]); X[B+3]=EX(X[B+3]); PIN(X); SBAR(); }while(0)
  #define VRD(i) do{ vlo[i]=vtr(vp_+(((i)>>2)*4096+((i)&3)*1024)); vhi[i]=vtr(vp_+(((i)>>2)*4096+((i)&3)*1024+512)); }while(0)
  #define KRD(G,j) do{ if(G){ kload2(kf,kp0+sl_next,j); SBAR(); } }while(0)
  #define STEP(C0,C1,P0,P1,t,GK,GV,GL) do{ SBAR(); \
    const lds_cptr vp_=vp0+sl_prev; \
    VRD(0); SBAR(); float sacc=(P0[0]+P0[1]); \
    GAPA(C0=__builtin_amdgcn_mfma_f32_32x32x16_bf16(kf[0],qr[0],negm,0,0,0), P0[2],P0[3],P0[4],P0[5],     pw0[0]=PKW(P0,0), pw0[1]=PKW(P0,2), pw0); \
    VRD(4); SBAR(); GAPA(C1=__builtin_amdgcn_mfma_f32_32x32x16_bf16(kf[1],qr[0],negm,0,0,0), P0[6],P0[7],P0[8],P0[9],     pw0[2]=PKW(P0,4), pw0[3]=PKW(P0,6), pw0); \
    VRD(1); SBAR(); GAPA(C0=__builtin_amdgcn_mfma_f32_32x32x16_bf16(kf[2],qr[1],C0,0,0,0),   P0[10],P0[11],P0[12],P0[13], pw1[0]=PKW(P0,8), pw1[1]=PKW(P0,10), pw1); \
    VRD(5); SBAR(); GAPA(C1=__builtin_amdgcn_mfma_f32_32x32x16_bf16(kf[3],qr[1],C1,0,0,0),   P0[14],P0[15],P1[0],P1[1],   pw1[2]=PKW(P0,12),pw1[3]=PKW(P0,14), pw1); \
    VRD(2); SBAR(); GAPA(C0=__builtin_amdgcn_mfma_f32_32x32x16_bf16(kf[4],qr[2],C0,0,0,0),   P1[2],P1[3],P1[4],P1[5],     pw2[0]=PKW(P1,0), pw2[1]=PKW(P1,2), pw2); \
    VRD(6); SBAR(); GAPA(C1=__builtin_amdgcn_mfma_f32_32x32x16_bf16(kf[5],qr[2],C1,0,0,0),   P1[6],P1[7],P1[8],P1[9],     pw2[2]=PKW(P1,4), pw2[3]=PKW(P1,6), pw2); \
    VRD(3); SBAR(); GAPA(C0=__builtin_amdgcn_mfma_f32_32x32x16_bf16(kf[6],qr[3],C0,0,0,0),   P1[10],P1[11],P1[12],P1[13], pw3[0]=PKW(P1,8), pw3[1]=PKW(P1,10), pw3); \
    VRD(7); SBAR(); GAPA(C1=__builtin_amdgcn_mfma_f32_32x32x16_bf16(kf[7],qr[3],C1,0,0,0),   P1[14],P1[15],0.f,0.f,       pw3[2]=PKW(P1,12),pw3[3]=PKW(P1,14), pw3); \
    if(MODE==1){ const bool sp_=((selmask>>(((t)-1)>>2))&1u)!=0u; sacc=sp_?sacc:0.f; \
      _Pragma("unroll") for(int i_=0;i_<4;++i_){ pw0[i_]=sp_?pw0[i_]:0u; pw1[i_]=sp_?pw1[i_]:0u; pw2[i_]=sp_?pw2[i_]:0u; pw3[i_]=sp_?pw3[i_]:0u; } } \
    l_reg+=sacc; \
    if(GK){DMA_K((t)+3,sl_cur);} if(GV){DMA_V((t)+1,sl_next);} \
    CMASK(C0,C1,t); BIAS(C0,C1,t); \
    { float a=MX3(C0[0],C0[1],C1[0]),b=MX3(C0[2],C0[3],C1[1]); a=MX3(a,C1[2],C1[3]); \
      _Pragma("unroll") for(int r=4;r<16;r+=4){a=MX3(a,C0[r],C0[r+1]);b=MX3(b,C0[r+2],C0[r+3]);a=MX3(a,C1[r],C1[r+1]);b=MX3(b,C1[r+2],C1[r+3]);} \
      float rm=__builtin_fmaxf(a,b); { auto rr=__builtin_amdgcn_permlane32_swap(__float_as_uint(rm),__float_as_uint(rm),false,false); rm=__builtin_fmaxf(__uint_as_float(rr[0]),__uint_as_float(rr[1])); } \
      resc=false; \
      if(__builtin_expect(__any(rm>(float)THRL),0)){ const float dl=__builtin_fmaxf(rm,0.f); mhat+=dl; \
        _Pragma("unroll") for(int r=0;r<16;++r){C0[r]-=dl;C1[r]-=dl;} \
        _Pragma("unroll") for(int r=0;r<16;++r)negm[r]=-mhat; asm volatile("":"+v"(negm)); \
        const float f=__builtin_amdgcn_exp2f(-dl); l_reg*=f; if(hi==0)wsf[r32]=f; resc=true; } } \
    SBAR(); \
    GAPB(o[0]=__builtin_amdgcn_mfma_f32_32x32x16_bf16(PAF(0),VFR(0),o[0],0,0,0), C0,0); \
    GAPB(o[1]=__builtin_amdgcn_mfma_f32_32x32x16_bf16(PAF(0),VFR(4),o[1],0,0,0), C0,4); \
    KRD(GL,0); GAPB(o[0]=__builtin_amdgcn_mfma_f32_32x32x16_bf16(PAF(1),VFR(1),o[0],0,0,0), C0,8); \
    KRD(GL,1); GAPB(o[1]=__builtin_amdgcn_mfma_f32_32x32x16_bf16(PAF(1),VFR(5),o[1],0,0,0), C0,12); \
    KRD(GL,2); GAPB(o[0]=__builtin_amdgcn_mfma_f32_32x32x16_bf16(PAF(2),VFR(2),o[0],0,0,0), C1,0); \
    KRD(GL,3); GAPB(o[1]=__builtin_amdgcn_mfma_f32_32x32x16_bf16(PAF(2),VFR(6),o[1],0,0,0), C1,4); \
    GAPB(o[0]=__builtin_amdgcn_mfma_f32_32x32x16_bf16(PAF(3),VFR(3),o[0],0,0,0), C1,8); \
    GAPB(o[1]=__builtin_amdgcn_mfma_f32_32x32x16_bf16(PAF(3),VFR(7),o[1],0,0,0), C1,12); \
    }while(0)
  int t=1;
  #undef CMASK
  #define CMASK(P0,P1,t) do{}while(0)
  for(;t+5<NT;t+=2){
    STEP(pB0,pB1,pA0,pA1,t,true,true,true);     WAIT_BAR(2); RESC(); ROT();
    STEP(pA0,pA1,pB0,pB1,t+1,true,true,true);   WAIT_BAR(2); RESC(); ROT();
  }
  #undef CMASK
  #define CMASK(P0,P1,t) do{int jb_=(t)-(NT-4); if(jb_>=0)cmask(P0,P1,jb_,qrel,hi);}while(0)
  #define ENDW(tt) do{ if((tt)+3<NT){WAIT_BAR(2);} else if((tt)+2<NT){WAIT_BAR(1);} else {WAIT_BAR(0);} }while(0)
  for(;t+1<NT;t+=2){
    STEP(pB0,pB1,pA0,pA1,t,(t+3<NT),(t+1<NT),(t+1<NT));       ENDW(t);   RESC(); ROT();
    STEP(pA0,pA1,pB0,pB1,t+1,(t+4<NT),(t+2<NT),(t+2<NT));     ENDW(t+1); RESC(); ROT();
  }
  STEP(pB0,pB1,pA0,pA1,NT-1,false,false,false); RESC();
  { float sacc=pB0[0]+pB0[1]; _Pragma("unroll") for(int r=2;r<16;++r)sacc+=pB0[r]; _Pragma("unroll") for(int r=0;r<16;++r)sacc+=pB1[r]; l_reg+=sacc;
    pw0=(u32x4){PKW(pB0,0),PKW(pB0,2),PKW(pB0,4),PKW(pB0,6)};pw1=(u32x4){PKW(pB0,8),PKW(pB0,10),PKW(pB0,12),PKW(pB0,14)};pw2=(u32x4){PKW(pB1,0),PKW(pB1,2),PKW(pB1,4),PKW(pB1,6)};pw3=(u32x4){PKW(pB1,8),PKW(pB1,10),PKW(pB1,12),PKW(pB1,14)};
    SBAR(); pv(o,vb0+sl_cur,PAF(0),PAF(1),PAF(2),PAF(3)); }
  #undef PKW
  #undef PAF
  #undef VFR
  #undef PIN
  #undef MX3
  #undef GAPA
  #undef GAPB
  #undef EX
  #undef VRD
  #undef KRD
  #undef STEP
  #undef ENDW
  {auto rr=__builtin_amdgcn_permlane32_swap(__float_as_uint(l_reg),__float_as_uint(l_reg),false,false);l_reg=__uint_as_float(rr[0])+__uint_as_float(rr[1]);}
  if(hi==0)wsf[32+r32]=l_reg;asm volatile("s_waitcnt lgkmcnt(0)":::"memory");
  float rli[16];
  #pragma unroll
  for(int r=0;r<16;++r)rli[r]=__builtin_amdgcn_rcpf(wsf[32+crow(r,hi)]);
  bf16*Ow=Oh+(long)(q0+wid*QBLK)*opitch;
  { bf16*stg=(bf16*)(shm+LDS_OST)+wid*2048;
    #pragma unroll
    for(int r=0;r<16;++r){const int orow=crow(r,hi);
      #pragma unroll
      for(int d0=0;d0<2;++d0)stg[orow*64+d0*32+r32]=__float2bfloat16(o[d0][r]*rli[r]);}
    asm volatile("s_waitcnt lgkmcnt(0)":::"memory");
    #pragma unroll
    for(int i=0;i<4;++i){const int row=i*8+(lane>>3),ch=lane&7; const u32x4 v=*(const u32x4*)(stg+row*64+ch*8); ATTN_STORE16(Ow+(long)row*opitch+ch*8,v);} }
  asm volatile("s_waitcnt lgkmcnt(0)\n\ts_barrier":::"memory");
  #undef DMA_K
  #undef DMA_V
  #undef CMASK
  #undef BIAS
  #undef START
  #undef RESC
  #undef ROT
}
constexpr int ATTN_LDS_BYTES=LDS_BYTES;
#undef SBAR
#undef WAIT_BAR
}
struct Ctx { LAS unsigned char* lds; unsigned char* ldsg; int tid, lane, wave, G, bx, gw, ngw, gtid, ngt; };
__device__ __forceinline__ Ctx make_ctx(unsigned char* lds_raw) {
    Ctx X; int t = threadIdx.x; asm volatile("" : "+v"(t));
    X.lds = (LAS unsigned char*)lds_raw; X.ldsg = lds_raw; X.tid = t; X.lane = t & 63; X.wave = __builtin_amdgcn_readfirstlane(t >> 6);
    X.G = gridDim.x; X.bx = blockIdx.x; X.gw = X.bx * 8 + X.wave; X.ngw = X.G * 8; X.gtid = X.bx * 512 + t; X.ngt = X.G * 512; return X; }


__device__ __forceinline__ int map_row(int mode, int n) {
    if (mode == 1) return n < 2560 ? n : (n < 2576 ? 5632 + (n - 2560) : n - 16);
    if (mode == 2) return ((n >> 7) << 8) + (n & 127);
    if (mode == 3) return ((n >> 7) << 8) + 128 + (n & 127);
    return n;
}
constexpr int CVT_SCR = 8448;
struct CvtJob { const float* W; void* WT; int K, N, mode, kb, nb; };
__device__ __forceinline__ void cvt_load(f32x4 (&v)[8], const CvtJob& J, int lane) {
    const int nn = J.nb * 32 + 4 * (lane & 7), kr = lane >> 3; const bool okc = nn < J.N;
#pragma unroll
    for (int i = 0; i < 8; ++i) { const f32x4 x = __builtin_nontemporal_load((const f32x4*)(J.W + (size_t)(J.kb * 64 + 8 * i + kr) * J.N + (okc ? nn : 0))); v[i] = okc ? x : (f32x4){0.f, 0.f, 0.f, 0.f}; }
}
__device__ __forceinline__ void cvt_emit(const f32x4 (&v)[8], const CvtJob& J, bool fp8, LAS float* scr, int lane) {
    const int k0 = J.kb * 64, n0 = J.nb * 32, nq = lane & 7, kr = lane >> 3;
#pragma unroll
    for (int i = 0; i < 8; ++i) { LAS float* d = scr + (8 * i + kr) * 33 + 4 * nq; d[0] = v[i][0]; d[1] = v[i][1]; d[2] = v[i][2]; d[3] = v[i][3]; }
    LDS_WAIT(); asm volatile("" ::: "memory");
    const int c = lane >> 3, nl = lane & 7;
    if (fp8) {
        unsigned char* WT = (unsigned char*)J.WT;
#pragma unroll
        for (int j = 0; j < 4; ++j) { const int n = 8 * j + nl; const LAS float* s = scr + (8 * c) * 33 + n;
            v2u o; o.x = pg8::pk4_fp8(s[0 * 33] * pg8::W8_SCALE, s[1 * 33] * pg8::W8_SCALE, s[2 * 33] * pg8::W8_SCALE, s[3 * 33] * pg8::W8_SCALE);
            o.y = pg8::pk4_fp8(s[4 * 33] * pg8::W8_SCALE, s[5 * 33] * pg8::W8_SCALE, s[6 * 33] * pg8::W8_SCALE, s[7 * 33] * pg8::W8_SCALE);
            if (n0 + n < J.N) *(v2u*)(WT + (size_t)map_row(J.mode, n0 + n) * J.K + k0 + 8 * c) = o; }
    } else {
        bf16* WT = (bf16*)J.WT;
#pragma unroll
        for (int j = 0; j < 4; ++j) { const int n = 8 * j + nl; const LAS float* s = scr + (8 * c) * 33 + n;
            v4u o; o.x = pk2(s[0 * 33], s[1 * 33]); o.y = pk2(s[2 * 33], s[3 * 33]); o.z = pk2(s[4 * 33], s[5 * 33]); o.w = pk2(s[6 * 33], s[7 * 33]);
            if (n0 + n < J.N) *(v4u*)(WT + (size_t)map_row(J.mode, n0 + n) * J.K + k0 + 8 * c) = o; }
    }
    LDS_WAIT(); asm volatile("" ::: "memory");
}
__device__ __forceinline__ void cvt_tile(const float* __restrict__ W, int K, int N, void* __restrict__ WTv, int mode, bool fp8, LAS float* scr, int kb, int nb, int lane) {
    const CvtJob J{W, WTv, K, N, mode, kb, nb}; f32x4 v[8]; cvt_load(v, J, lane); cvt_emit(v, J, fp8, scr, lane);
}
constexpr int DEF_DENSE = 3 * 2816, DEF_TILES = DEF_DENSE + 24 * 3584, DEF_PER_ITEM = 64, DEF_ITEMS = DEF_TILES / DEF_PER_ITEM, DEF_ITEMS_L = DEF_ITEMS / 2;
static_assert(DEF_TILES % DEF_PER_ITEM == 0 && DEF_ITEMS % 2 == 0, "deferred conversion items");
struct DefIn { const float *dw1, *dw3, *dw2, *ew1, *ew3, *ew2; unsigned char* ws; };
__device__ __forceinline__ CvtJob def_job(const DefIn& I, int t) {
    CvtJob J; int nbn, r;
    if (t < DEF_DENSE) { const int j = t / 2816; r = t % 2816;
        if (j == 0) { J.W = I.dw1; J.K = DM; J.N = FFD; J.WT = I.ws + WS_W13; J.mode = 2; nbn = 176; }
        else if (j == 1) { J.W = I.dw3; J.K = DM; J.N = FFD; J.WT = I.ws + WS_W13; J.mode = 3; nbn = 176; }
        else { J.W = I.dw2; J.K = FFD; J.N = DM; J.WT = I.ws + WS_W2; J.mode = 0; nbn = 64; } }
    else { t -= DEF_DENSE; const int j = t / 3584; r = t % 3584;
        if (j < 16) { const int e = j >> 1, wh = j & 1; J.W = (wh ? I.ew3 : I.ew1) + (size_t)e * DM * FFE; J.K = DM; J.N = FFE; J.WT = I.ws + WS_W13E + (size_t)e * 2 * FFE * DM; J.mode = 2 + wh; nbn = 224; }
        else { const int e = j - 16; J.W = I.ew2 + (size_t)e * FFE * DM; J.K = FFE; J.N = DM; J.WT = I.ws + WS_W2E + (size_t)e * DM * FFE; J.mode = 0; nbn = 64; } }
    J.kb = r / nbn; J.nb = r % nbn; return J;
}
__device__ __forceinline__ void cvt8_load(f32x4 (&v)[16], const CvtJob& J, int lane) {
    const float* p = J.W + (size_t)(J.kb * 128 + 16 * (lane >> 3)) * J.N + J.nb * 32 + 4 * (lane & 7);
#pragma unroll
    for (int i = 0; i < 16; ++i) v[i] = __builtin_nontemporal_load((const f32x4*)(p + (size_t)i * J.N));
}
__device__ __forceinline__ void cvt8_emit(const f32x4 (&v)[16], const CvtJob& J, int lane) {
    unsigned E[4][4];
#pragma unroll
    for (int b = 0; b < 4; ++b) {
        unsigned D[4];
#pragma unroll
        for (int i = 0; i < 4; ++i) D[i] = pg8::pk4_fp8_w(v[4 * b + i][0], v[4 * b + i][1], v[4 * b + i][2], v[4 * b + i][3]);
        const unsigned t0 = __builtin_amdgcn_perm(D[1], D[0], 0x05010400u), t1 = __builtin_amdgcn_perm(D[1], D[0], 0x07030602u);
        const unsigned t2 = __builtin_amdgcn_perm(D[3], D[2], 0x05010400u), t3 = __builtin_amdgcn_perm(D[3], D[2], 0x07030602u);
        E[b][0] = __builtin_amdgcn_perm(t2, t0, 0x05040100u); E[b][1] = __builtin_amdgcn_perm(t2, t0, 0x07060302u);
        E[b][2] = __builtin_amdgcn_perm(t3, t1, 0x05040100u); E[b][3] = __builtin_amdgcn_perm(t3, t1, 0x07060302u);
    }
    unsigned char* WT = (unsigned char*)J.WT; const int n = J.nb * 32 + 4 * (lane & 7), kk = J.kb * 128 + 16 * (lane >> 3);
#pragma unroll
    for (int jn = 0; jn < 4; ++jn) { v4u o; o.x = E[0][jn]; o.y = E[1][jn]; o.z = E[2][jn]; o.w = E[3][jn]; *(v4u*)(WT + (size_t)map_row(J.mode, n + jn) * J.K + kk) = o; }
}
__device__ __forceinline__ void def_wave_item(const DefIn& I, int t0, LAS float* scr, int lane) {
    (void)scr;
    CvtJob J0 = def_job(I, t0);
#pragma unroll 1
    for (int b = 0; b < 2; ++b) {
        CvtJob J1 = J0; J1.nb = J0.nb + 1;
        f32x4 v0[16], v1[16];
        cvt8_load(v0, J0, lane); cvt8_load(v1, J1, lane);
        cvt8_emit(v0, J0, lane); cvt8_emit(v1, J1, lane);
        J0.nb += 2;
    }
}
struct P0In { const float *c, *w_ada, *w_in, *w_out, *dw1, *dw3, *dw2, *ew1, *ew3, *ew2; unsigned char* ws; };
__device__ __forceinline__ void mod_item(const Ctx& X, const float* __restrict__ w_ada, float* __restrict__ modp, int l, int r) {
    const LAS float* cact = (const LAS float*)(X.lds); LAS f32x4* red = (LAS f32x4*)(X.lds + 8192);
    const int cg = r >> 2, ks = r & 3;
    const float* Wb = w_ada + (size_t)l * DM * NMOD + (size_t)(ks * 512 + X.wave * 64) * NMOD + cg * 256 + 4 * X.lane;
    f32x4 acc = {0.f, 0.f, 0.f, 0.f};
#pragma unroll 1
    for (int i0 = 0; i0 < 64; i0 += 16) { f32x4 w[16];
#pragma unroll
        for (int i = 0; i < 16; ++i) w[i] = __builtin_nontemporal_load((const f32x4*)(Wb + (size_t)(i0 + i) * NMOD));
        asm volatile("" ::: "memory");
#pragma unroll
        for (int i = 0; i < 16; ++i) acc += w[i] * cact[ks * 512 + X.wave * 64 + i0 + i]; }
    red[X.wave * 64 + X.lane] = acc;
    __syncthreads();
    if (X.tid < 256) { float s = 0.f;
#pragma unroll
        for (int w = 0; w < 8; ++w) s += ((LAS float*)red)[(w * 64 + (X.tid >> 2)) * 4 + (X.tid & 3)];
        modp[(size_t)(ks * 2 + l) * NMOD + cg * 256 + X.tid] = s; }
    __syncthreads();
}
constexpr int P0_IA = 32 * 177, P0_IB = 32 * 64;
__device__ __forceinline__ CvtJob inout_job(const P0In& I, int l, int t, bool& fp8) {
    CvtJob J;
    if (t < P0_IA) { J.W = I.w_in + (size_t)l * DM * NIN; J.K = DM; J.N = NIN; J.WT = I.ws + WS_WIN + (size_t)l * NPROJ_T * DM; J.mode = 1; J.kb = t / 177; J.nb = t % 177; fp8 = true; }
    else { t -= P0_IA; J.W = I.w_out + (size_t)l * DM * DM; J.K = DM; J.N = DM; J.mode = 0; J.kb = t / 64; J.nb = t % 64;
#if OUTPROJ_FP8
        J.WT = I.ws + WS_WOUT + (size_t)l * DM * DM; fp8 = true;
#else
        J.WT = (bf16*)(I.ws + WS_WOUT) + (size_t)l * DM * DM; fp8 = false;
#endif
    }
    return J;
}
__device__ __forceinline__ void inout_run(const P0In& I, int l, int t0, int step, int tend, LAS float* scr, int lane) {
    const int last = tend - 1; bool fa = false, fb = false; f32x4 va[8], vb[8];
    CvtJob Ja = inout_job(I, l, t0 < tend ? t0 : last, fa), Jb; cvt_load(va, Ja, lane);
    for (int t = t0; t < tend; t += 2 * step) { const int t1 = t + step, t2 = t + 2 * step;
        Jb = inout_job(I, l, t1 < tend ? t1 : last, fb); cvt_load(vb, Jb, lane);
        cvt_emit(va, Ja, fa, scr, lane);
        Ja = inout_job(I, l, t2 < tend ? t2 : last, fa); cvt_load(va, Ja, lane);
        if (t1 < tend) cvt_emit(vb, Jb, fb, scr, lane); }
}
__device__ __forceinline__ void inout_tile(const P0In& I, int l, int t, LAS float* scr, int lane) {
    if (t < P0_IA) cvt_tile(I.w_in + (size_t)l * DM * NIN, DM, NIN, I.ws + WS_WIN + (size_t)l * NPROJ_T * DM, 1, true, scr, t / 177, t % 177, lane);
#if OUTPROJ_FP8
    else if (t < P0_IA + P0_IB) { t -= P0_IA; cvt_tile(I.w_out + (size_t)l * DM * DM, DM, DM, I.ws + WS_WOUT + (size_t)l * DM * DM, 0, true, scr, t / 64, t % 64, lane); }
#else
    else if (t < P0_IA + P0_IB) { t -= P0_IA; cvt_tile(I.w_out + (size_t)l * DM * DM, DM, DM, (bf16*)(I.ws + WS_WOUT) + (size_t)l * DM * DM, 0, false, scr, t / 64, t % 64, lane); }
#endif
}
__device__ __forceinline__ void p0_prologue(const Ctx& X, const P0In& I) {
    LAS float* cact = (LAS float*)(X.lds);
    for (int k = X.tid; k < DM; k += 512) cact[k] = siluf(I.c[k]);
    __syncthreads();
    for (int bi = X.bx; bi < 192; bi += X.G) mod_item(X, I.w_ada, (float*)(I.ws + WS_MODP), 0, bi);
    { const v4u z = {0u, 0u, 0u, 0u};
      for (int i = X.gtid; i < 2 * 30720; i += X.ngt) { const int l = i / 30720, r = i % 30720;
          *(v4u*)(I.ws + WS_WIN + (size_t)l * NPROJ_T * DM + (size_t)NIN * DM + (size_t)r * 16) = z; } }
    __syncthreads();
    LAS float* scr = (LAS float*)(X.lds + X.wave * CVT_SCR);
    inout_run(I, 0, X.gw, X.ngw, P0_IA + P0_IB, scr, X.lane);
}
constexpr int EXTRA_MOD = 192, EXTRA_TILE_ITEMS = (P0_IA + P0_IB + 63) / 64, EXTRA_ITEMS = EXTRA_MOD + EXTRA_TILE_ITEMS;

template <bool ROUTER, bool OUT8, bool IN16>
__device__ __forceinline__ void rms_rows(const Ctx& X, const void* __restrict__ Xin, void* __restrict__ Hv, const LAS float* sh, const LAS float* gs,
                                         const LAS float* router_w_lds, unsigned* cnt, unsigned* route) {
    f32x4 nv[8]; v2u nr[8];
    if (X.gw < NTOK) {
        if (IN16) { const v2u* xr = (const v2u*)((const bf16*)Xin + (size_t)X.gw * DM) + X.lane;
#pragma unroll
            for (int j = 0; j < 8; ++j) nr[j] = xr[64 * j]; }
        else { const f32x4* xr = (const f32x4*)((const float*)Xin + (size_t)X.gw * DM) + X.lane;
#pragma unroll
            for (int j = 0; j < 8; ++j) nv[j] = xr[64 * j]; } }
    for (int t = X.gw; t < NTOK; t += X.ngw) {
        f32x4 v[8]; float s = 0.f;
#pragma unroll
        for (int j = 0; j < 8; ++j) { if (IN16) v[j] = (f32x4){bflo(nr[j].x), bfhi(nr[j].x), bflo(nr[j].y), bfhi(nr[j].y)}; else v[j] = nv[j]; }
        if (t + X.ngw < NTOK) {
            if (IN16) { const v2u* xr = (const v2u*)((const bf16*)Xin + (size_t)(t + X.ngw) * DM) + X.lane;
#pragma unroll
                for (int j = 0; j < 8; ++j) nr[j] = xr[64 * j]; }
            else { const f32x4* xr = (const f32x4*)((const float*)Xin + (size_t)(t + X.ngw) * DM) + X.lane;
#pragma unroll
                for (int j = 0; j < 8; ++j) nv[j] = xr[64 * j]; } }
        asm volatile("" ::: "memory");
#pragma unroll
        for (int j = 0; j < 8; ++j) s += (v[j][0] * v[j][0] + v[j][1] * v[j][1]) + (v[j][2] * v[j][2] + v[j][3] * v[j][3]);
        s = wave_sum(s);
        const float r = 1.0f / sqrtf(s * (1.0f / DM) + EPSF);
        float lg[8]; unsigned hq[8];
        if (ROUTER) {
#pragma unroll
            for (int e = 0; e < 8; ++e) lg[e] = 0.f; }
#pragma unroll
        for (int j = 0; j < 8; ++j) { const int c = 4 * X.lane + 256 * j;
            const f32x4 g4 = *(const LAS f32x4*)(gs + c), s4 = *(const LAS f32x4*)(sh + c);
            const f32x4 h = v[j] * r * g4 + s4;
            if (OUT8) { const unsigned q_ = pg8::pk4_fp8(h[0] * pg8::A8_SCALE, h[1] * pg8::A8_SCALE, h[2] * pg8::A8_SCALE, h[3] * pg8::A8_SCALE); if (ROUTER) hq[j] = q_; else *(unsigned*)((unsigned char*)Hv + (size_t)t * DM + c) = q_; }
            else { v2u o; o.x = pk2(h[0], h[1]); o.y = pk2(h[2], h[3]); *(v2u*)((bf16*)Hv + (size_t)t * DM + c) = o; }
            if (ROUTER) {
#pragma unroll
                for (int e = 0; e < 8; ++e) { const f32x4 w = *(const LAS f32x4*)((const LAS float*)router_w_lds + e * DM + c);
                    lg[e] += (h[0] * w[0] + h[1] * w[1]) + (h[2] * w[2] + h[3] * w[3]); } }
        }
        if (ROUTER) {
#pragma unroll
            for (int e = 0; e < 8; ++e) lg[e] = wave_sum(lg[e]);
            int e0 = 0; float m0 = lg[0];
#pragma unroll
            for (int e = 1; e < 8; ++e) if (lg[e] > m0) { m0 = lg[e]; e0 = e; }
            int e1 = -1; float m1 = -INFINITY;
#pragma unroll
            for (int e = 0; e < 8; ++e) if (e != e0 && lg[e] > m1) { m1 = lg[e]; e1 = e; }
            const float w0 = 1.0f / (1.0f + __expf(m1 - m0)), w1 = 1.0f - w0;
            unsigned p0 = 0u, p1 = 0u;
            if (X.lane == 0) {
                p0 = __hip_atomic_fetch_add(cnt + e0, 1u, RLX_AGENT); p1 = __hip_atomic_fetch_add(cnt + e1, 1u, RLX_AGENT);
                unsigned* rt = route + (size_t)t * 8;
                rt[0] = (unsigned)e0; rt[1] = (unsigned)e1; rt[2] = p0; rt[3] = p1; rt[4] = __float_as_uint(w0); rt[5] = __float_as_uint(w1); }
            p0 = (unsigned)__builtin_amdgcn_readfirstlane((int)p0); p1 = (unsigned)__builtin_amdgcn_readfirstlane((int)p1);
            unsigned char* d0 = (unsigned char*)Hv + ((size_t)e0 * NTOK + p0) * DM + 4 * X.lane; unsigned char* d1 = (unsigned char*)Hv + ((size_t)e1 * NTOK + p1) * DM + 4 * X.lane;
#pragma unroll
            for (int j = 0; j < 8; ++j) { *(unsigned*)(d0 + 256 * j) = hq[j]; *(unsigned*)(d1 + 256 * j) = hq[j]; }
        }
    }
}

struct P3In { const bf16* proj; const float* dtraw; const float *conv_w, *conv_b, *dt_bias, *a_log; bf16* xc; float *dtv, *acs, *km; };
__device__ __forceinline__ void p3_conv(const Ctx& X, const P3In& I) {
    LAS float* cwL = (LAS float*)(X.lds);
    __syncthreads();
    for (int i = X.tid; i < 4 * 1536; i += 512) cwL[i] = I.conv_w[i];
    for (int i = X.tid; i < 1536; i += 512) cwL[4 * 1536 + i] = I.conv_b[i];
    __syncthreads();
#define CONV_LOAD(dst, idx_) do { const int t_ = 4 * ((idx_) / 192), ch_ = ((idx_) % 192) * 8; \
        _Pragma("unroll") for (int j = 0; j < 7; ++j) { const int tt_ = t_ - 3 + j; dst[j] = *(const v4u*)(I.proj + (size_t)(tt_ < 0 ? 0 : tt_) * NPROJ + C_XBC + ch_); } } while (0)
#define CONV_ITEM(src, idx_) do { const int t0 = 4 * ((idx_) / 192), ch = ((idx_) % 192) * 8; \
        const f32x4 b0 = *(const LAS f32x4*)(cwL + 4 * 1536 + ch), b1 = *(const LAS f32x4*)(cwL + 4 * 1536 + ch + 4); f32x4 wa[4], wb[4]; \
        _Pragma("unroll") for (int j = 0; j < 4; ++j) { wa[j] = *(const LAS f32x4*)(cwL + j * 1536 + ch); wb[j] = *(const LAS f32x4*)(cwL + j * 1536 + ch + 4); } \
        _Pragma("unroll") for (int o_ = 0; o_ < 4; ++o_) { const int t = t0 + o_; float a[8] = {b0[0], b0[1], b0[2], b0[3], b1[0], b1[1], b1[2], b1[3]}; \
            _Pragma("unroll") for (int j = 0; j < 4; ++j) { v4u raw = src[o_ + j]; if (t - 3 + j < 0) raw = (v4u){0u, 0u, 0u, 0u}; \
                a[0] += wa[j][0] * bflo(raw.x); a[1] += wa[j][1] * bfhi(raw.x); a[2] += wa[j][2] * bflo(raw.y); a[3] += wa[j][3] * bfhi(raw.y); \
                a[4] += wb[j][0] * bflo(raw.z); a[5] += wb[j][1] * bfhi(raw.z); a[6] += wb[j][2] * bflo(raw.w); a[7] += wb[j][3] * bfhi(raw.w); } \
            v4u o; o.x = pk2(siluf(a[0]), siluf(a[1])); o.y = pk2(siluf(a[2]), siluf(a[3])); o.z = pk2(siluf(a[4]), siluf(a[5])); o.w = pk2(siluf(a[6]), siluf(a[7])); \
            *(v4u*)(I.xc + (size_t)t * 1536 + ch) = o; } } while (0)
    { constexpr int NIT = (NTOK / 4) * 192; v4u ra[7], rb[7];
      CONV_LOAD(ra, (X.gtid < NIT ? X.gtid : NIT - 1));
      for (int idx = X.gtid; idx < NIT; idx += 2 * X.ngt) {
          const int i1 = idx + X.ngt, i2 = idx + 2 * X.ngt;
          CONV_LOAD(rb, (i1 < NIT ? i1 : NIT - 1));
          CONV_ITEM(ra, idx);
          CONV_LOAD(ra, (i2 < NIT ? i2 : NIT - 1));
          if (i1 < NIT) CONV_ITEM(rb, i1); } }
#undef CONV_LOAD
#undef CONV_ITEM
    for (int wi = X.gw; wi < 512; wi += X.ngw) {
        const int c = wi >> 4, h = wi & 15; const float a = -__expf(I.a_log[h]), db = I.dt_bias[h];
        float dv[4], cs[4]; float run = 0.f;
        float xr_[4];
#pragma unroll
        for (int i = 0; i < 4; ++i) xr_[i] = I.dtraw[(size_t)(c * 256 + 4 * X.lane + i) * 16 + h];
        asm volatile("" ::: "memory");
#pragma unroll
        for (int i = 0; i < 4; ++i) { const float x = xr_[i] + db;
            dv[i] = x > 20.f ? x : log1pf(__expf(x)); run += dv[i] * a; cs[i] = run; }
        float tot = run;
#pragma unroll
        for (int o = 1; o < 64; o <<= 1) { const float n = __shfl_up(tot, o); if (X.lane >= o) tot += n; }
        const float ex = tot - run;
#pragma unroll
        for (int i = 0; i < 4; ++i) { const int t = c * 256 + 4 * X.lane + i; I.dtv[(size_t)t * 16 + h] = dv[i]; I.acs[(size_t)t * 16 + h] = ex + cs[i]; }
    }
    for (int wi = X.gw; wi < 2048; wi += X.ngw) {
        const int j = wi >> 6, hd = (wi >> 3) & 7, rs = wi & 7;
        const bf16* p = I.proj + (size_t)(j * 256 + rs * 32) * NPROJ + C_MK + hd * 64 + X.lane; float s = 0.f;
        bf16 rw[32];
#pragma unroll
        for (int r = 0; r < 32; ++r) rw[r] = p[(size_t)r * NPROJ];
        asm volatile("" ::: "memory");
#pragma unroll
        for (int r = 0; r < 32; ++r) s += bf1(rw[r]);
        I.km[(size_t)rs * 16384 + ((size_t)hd * 32 + j) * 64 + X.lane] = s;
    }
}

typedef short bf16x8 __attribute__((ext_vector_type(8)));
typedef float f32x16 __attribute__((ext_vector_type(16)));
__device__ __forceinline__ int crow(int r, int hi) { return (r & 3) + 8 * (r >> 2) + 4 * hi; }
constexpr int SSD_PITCH = 264;
constexpr int SSD_XT = 0, SSD_BT = 33792, SSD_MS = SSD_BT + 67584, SSD_AC = SSD_MS + 8 * 2560, SSD_LDS = SSD_AC + 2048;
static_assert(SSD_LDS <= LDSCTL_OFF, "SSD LDS map");
__device__ __forceinline__ void ssd_a_unit(const Ctx& X, const bf16* __restrict__ xc, const float* __restrict__ dtv, const float* __restrict__ acs, float* __restrict__ yraw, float* __restrict__ sst, int c, int h) {
    const int g = h >> 3, r = X.lane & 31, hh = X.lane >> 5, w = X.wave;
    LAS bf16* XT = (LAS bf16*)(X.lds + SSD_XT); LAS bf16* BT = (LAS bf16*)(X.lds + SSD_BT); LAS bf16* MS = (LAS bf16*)(X.lds + SSD_MS + w * 2560);
    LAS float* AC = (LAS float*)(X.lds + SSD_AC); LAS float* DV = AC + 256;
    const int l0 = 32 * w;
    const int s_ = X.tid >> 1, ph = X.tid & 1;
    v4u xs[4], bs[8]; float a_in = 0.f, d_in = 0.f;
    { const bf16* src = xc + (size_t)(c * 256 + s_) * 1536 + h * 64 + ph * 32;
#pragma unroll
      for (int i = 0; i < 4; ++i) xs[i] = *(const v4u*)(src + 8 * i); }
    if (X.tid < 256) { a_in = acs[(size_t)(c * 256 + X.tid) * 16 + h]; d_in = dtv[(size_t)(c * 256 + X.tid) * 16 + h]; }
    { const bf16* src = xc + (size_t)(c * 256 + s_) * 1536 + 1024 + g * 128 + ph * 64;
#pragma unroll
      for (int i = 0; i < 8; ++i) bs[i] = *(const v4u*)(src + 8 * i); }
    bf16x8 cf[8], bn[8];
    { const bf16* cp = xc + (size_t)(c * 256 + l0 + r) * 1536 + 1280 + g * 128 + 8 * hh; const bf16* bp = xc + (size_t)(c * 256 + r) * 1536 + 1024 + g * 128 + 8 * hh;
#pragma unroll
      for (int ks = 0; ks < 8; ++ks) { cf[ks] = *(const bf16x8*)(cp + 16 * ks); bn[ks] = *(const bf16x8*)(bp + 16 * ks); } }
    __syncthreads();
#pragma unroll
    for (int i = 0; i < 4; ++i) { const v4u v = xs[i]; LAS bf16* d = XT + (ph * 32 + 8 * i) * SSD_PITCH + s_;
        d[0 * SSD_PITCH] = (bf16)(v.x & 0xffffu); d[1 * SSD_PITCH] = (bf16)(v.x >> 16); d[2 * SSD_PITCH] = (bf16)(v.y & 0xffffu); d[3 * SSD_PITCH] = (bf16)(v.y >> 16);
        d[4 * SSD_PITCH] = (bf16)(v.z & 0xffffu); d[5 * SSD_PITCH] = (bf16)(v.z >> 16); d[6 * SSD_PITCH] = (bf16)(v.w & 0xffffu); d[7 * SSD_PITCH] = (bf16)(v.w >> 16); }
    if (X.tid < 256) { AC[X.tid] = a_in; DV[X.tid] = d_in; }
    __syncthreads();
    { const float wl = __expf(AC[255] - AC[s_]) * DV[s_];
#pragma unroll
      for (int i = 0; i < 8; ++i) { const v4u v = bs[i]; LAS bf16* d = BT + (ph * 64 + 8 * i) * SSD_PITCH + s_;
          d[0 * SSD_PITCH] = (bf16)f2bf(bflo(v.x) * wl); d[1 * SSD_PITCH] = (bf16)f2bf(bfhi(v.x) * wl); d[2 * SSD_PITCH] = (bf16)f2bf(bflo(v.y) * wl); d[3 * SSD_PITCH] = (bf16)f2bf(bfhi(v.y) * wl);
          d[4 * SSD_PITCH] = (bf16)f2bf(bflo(v.z) * wl); d[5 * SSD_PITCH] = (bf16)f2bf(bfhi(v.z) * wl); d[6 * SSD_PITCH] = (bf16)f2bf(bflo(v.w) * wl); d[7 * SSD_PITCH] = (bf16)f2bf(bfhi(v.w) * wl); } }
    float al[16];
#pragma unroll
    for (int q = 0; q < 16; ++q) al[q] = AC[l0 + crow(q, hh)];
    f32x16 y0 = {}, y1 = {};
    for (int j = 0; j <= w; ++j) {
        bf16x8 bc[8];
#pragma unroll
        for (int ks = 0; ks < 8; ++ks) bc[ks] = bn[ks];
        if (j < w) { const bf16* bp = xc + (size_t)(c * 256 + 32 * (j + 1) + r) * 1536 + 1024 + g * 128 + 8 * hh;
#pragma unroll
            for (int ks = 0; ks < 8; ++ks) bn[ks] = *(const bf16x8*)(bp + 16 * ks); }
        f32x16 acc = {};
#pragma unroll
        for (int ks = 0; ks < 8; ++ks) acc = __builtin_amdgcn_mfma_f32_32x32x16_bf16(cf[ks], bc[ks], acc, 0, 0, 0);
        const int s = 32 * j + r; const float as = AC[s], ds = DV[s];
#pragma unroll
        for (int q = 0; q < 16; ++q) { const int l = l0 + crow(q, hh); const float e = (s <= l) ? __expf(al[q] - as) : 0.f;
            MS[crow(q, hh) * 40 + r] = (bf16)f2bf(acc[q] * e * ds); }
        LDS_WAIT(); asm volatile("" ::: "memory");
#pragma unroll
        for (int k2 = 0; k2 < 2; ++k2) { const bf16x8 a = *(const LAS bf16x8*)(MS + r * 40 + 16 * k2 + 8 * hh);
            const bf16x8 b0 = *(const LAS bf16x8*)(XT + r * SSD_PITCH + 32 * j + 16 * k2 + 8 * hh), b1 = *(const LAS bf16x8*)(XT + (32 + r) * SSD_PITCH + 32 * j + 16 * k2 + 8 * hh);
            y0 = __builtin_amdgcn_mfma_f32_32x32x16_bf16(a, b0, y0, 0, 0, 0); y1 = __builtin_amdgcn_mfma_f32_32x32x16_bf16(a, b1, y1, 0, 0, 0); }
        LDS_WAIT(); asm volatile("" ::: "memory");
    }
#pragma unroll
    for (int q = 0; q < 16; ++q) { float* yp = yraw + (size_t)(c * 256 + l0 + crow(q, hh)) * 1024 + h * 64; yp[r] = y0[q]; yp[32 + r] = y1[q]; }
    __syncthreads();
    { const int pb = w & 1, nb = w >> 1; f32x16 sa = {};
#pragma unroll
      for (int ks = 0; ks < 16; ++ks) { const bf16x8 a = *(const LAS bf16x8*)(XT + (32 * pb + r) * SSD_PITCH + 16 * ks + 8 * hh), b = *(const LAS bf16x8*)(BT + (32 * nb + r) * SSD_PITCH + 16 * ks + 8 * hh);
          sa = __builtin_amdgcn_mfma_f32_32x32x16_bf16(a, b, sa, 0, 0, 0); }
#pragma unroll
      for (int q = 0; q < 16; ++q) sst[(((size_t)c * 16 + h) * 64 + 32 * pb + crow(q, hh)) * 128 + 32 * nb + r] = sa[q]; }
}
__device__ __forceinline__ void ssd_scan(const Ctx& X, const float* __restrict__ sst, const float* __restrict__ acs, bf16* __restrict__ hp) {
    for (int e = X.gtid; e < 131072; e += X.ngt) { const int h = e >> 13; float hv = 0.f;
        float sv[32], dv[32];
#pragma unroll
        for (int c = 0; c < 32; ++c) { sv[c] = sst[(size_t)c * 131072 + e]; dv[c] = acs[(size_t)(c * 256 + 255) * 16 + h]; }
#pragma unroll
        for (int c = 0; c < 32; ++c) { hp[(size_t)c * 131072 + e] = (bf16)f2bf(hv); hv = __expf(dv[c]) * hv + sv[c]; } }
}
__device__ __forceinline__ void ssd_c_unit(const Ctx& X, const bf16* __restrict__ xc, const float* __restrict__ acs, const bf16* __restrict__ hp, float* __restrict__ yraw, int c, int h) {
    const int g = h >> 3, r = X.lane & 31, hh = X.lane >> 5, l0 = 32 * X.wave;
    bf16x8 cf[8], hb0[8], hb1[8];
    float yv0[16], yv1[16], av[16];
    { const bf16* cp = xc + (size_t)(c * 256 + l0 + r) * 1536 + 1280 + g * 128 + 8 * hh;
      const bf16* h0 = hp + (((size_t)c * 16 + h) * 64 + r) * 128 + 8 * hh; const bf16* h1 = h0 + 32 * 128;
#pragma unroll
      for (int ks = 0; ks < 8; ++ks) { cf[ks] = *(const bf16x8*)(cp + 16 * ks); hb0[ks] = *(const bf16x8*)(h0 + 16 * ks); hb1[ks] = *(const bf16x8*)(h1 + 16 * ks); } }
#pragma unroll
    for (int q = 0; q < 16; ++q) { const int t = c * 256 + l0 + crow(q, hh); const float* yp = yraw + (size_t)t * 1024 + h * 64 + r; av[q] = acs[(size_t)t * 16 + h]; yv0[q] = yp[0]; yv1[q] = yp[32]; }
    f32x16 a0 = {}, a1 = {};
#pragma unroll
    for (int ks = 0; ks < 8; ++ks) { a0 = __builtin_amdgcn_mfma_f32_32x32x16_bf16(cf[ks], hb0[ks], a0, 0, 0, 0); a1 = __builtin_amdgcn_mfma_f32_32x32x16_bf16(cf[ks], hb1[ks], a1, 0, 0, 0); }
#pragma unroll
    for (int q = 0; q < 16; ++q) { const int t = c * 256 + l0 + crow(q, hh); float* yp = yraw + (size_t)t * 1024 + h * 64 + r; const float e = __expf(av[q]); yp[0] = yv0[q] + e * a0[q]; yp[32] = yv1[q] + e * a1[q]; }
}
__device__ __forceinline__ void build_bias_table(const Ctx& X, const float* __restrict__ rel_bias, LAS float* biasT) {
    float bn[4], bf_[4];
#pragma unroll
    for (int q = 0; q < 4; ++q) { const int idx0 = X.tid + 512 * q, idx = idx0 < 12 * 129 ? idx0 : 12 * 129 - 1; const int hh = idx / 129, d = idx % 129;
        int b; if (d < 16) b = d; else { b = 16 + (int)(logf((float)d / 16.0f) / 2.0794415416798357f * 16.0f); if (b > 31) b = 31; }
        bn[q] = rel_bias[b * 12 + hh]; bf_[q] = rel_bias[31 * 12 + hh]; }
    asm volatile("" ::: "memory");
#pragma unroll
    for (int q = 0; q < 4; ++q) { const int idx = X.tid + 512 * q; if (idx < 12 * 129) biasT[(idx / 129) * 132 + idx % 129] = (bn[q] - bf_[q]) * LOG2E; }
}

constexpr int ATT_POS = 86016, ATT_KMAX = ATT_POS + 32768, ATT_BIAS = ATT_KMAX + 512, ATT_KM = ATT_BIAS + 6400, ATT_END = ATT_KM + 8192;
static_assert(attn_body::ATTN_LDS_BYTES <= ATT_POS && ATT_END <= LDSCTL_OFF, "attention LDS map");
__device__ __forceinline__ void attn_phase(const Ctx& X, const bf16* __restrict__ proj, const float* __restrict__ km, const int* __restrict__ positions, const float* __restrict__ rel_bias,
                                           bf16* moba, bf16* diff, unsigned* qctr, volatile LAS unsigned* qslot, const DefIn& DI, const int def_base, const P0In& PI, const int extra) {
    LAS int* posL = (LAS int*)(X.lds + ATT_POS); LAS int* kmaxL = (LAS int*)(X.lds + ATT_KMAX); LAS float* biasT = (LAS float*)(X.lds + ATT_BIAS); LAS float* kmL = (LAS float*)(X.lds + ATT_KM);
    __syncthreads();
    { int pv[NTOK / 512];
#pragma unroll
      for (int q = 0; q < NTOK / 512; ++q) pv[q] = positions[X.tid + 512 * q];
      asm volatile("" ::: "memory");
#pragma unroll
      for (int q = 0; q < NTOK / 512; ++q) posL[X.tid + 512 * q] = pv[q]; }
    build_bias_table(X, rel_bias, biasT);
    __syncthreads();
    if (X.tid < 128) { int m = posL[64 * X.tid]; for (int k = 1; k < 64; ++k) { const int v = posL[64 * X.tid + k]; m = v > m ? v : m; } kmaxL[X.tid] = m; }
    __syncthreads();
    typedef attn_body::bf16 abf;
    int it = 0;
#define DRAIN_CONV() for (;; ++it) { if (X.tid == 0) qslot[it & 1] = __hip_atomic_fetch_add(qctr + 32, 1u, RLX_AGENT); __syncthreads(); \
        int ci = __builtin_amdgcn_readfirstlane((int)qslot[it & 1]); if (ci >= DEF_ITEMS_L + extra) { ++it; break; } \
        int ln = X.lane; asm volatile("" : "+v"(ln)); \
        if (ci < extra) { \
            if (ci < EXTRA_MOD) { int tl = X.tid; asm volatile("" : "+v"(tl)); LAS float* cact = (LAS float*)(X.lds); for (int k = tl; k < DM; k += 512) cact[k] = siluf(PI.c[k]); __syncthreads(); \
                mod_item(X, PI.w_ada, (float*)(PI.ws + WS_MODP), 1, ci); } \
            else { const int tb = (ci - EXTRA_MOD) * 64 + X.wave * 8, te = tb + 8 < P0_IA + P0_IB ? tb + 8 : P0_IA + P0_IB; if (tb < te) inout_run(PI, 1, tb, 1, te, (LAS float*)(X.lds + X.wave * CVT_SCR), ln); } \
            continue; } \
        ci -= extra; \
        { const int tt_ = (def_base + ci) * DEF_PER_ITEM + X.wave * (DEF_PER_ITEM / 8);        \
          def_wave_item(DI, tt_, (LAS float*)(X.lds + X.wave * CVT_SCR), ln); def_wave_item(DI, tt_ + 4, (LAS float*)(X.lds + X.wave * CVT_SCR), ln); } }
    if (((X.bx >> 3) & 7) < 3) { DRAIN_CONV(); }
    const unsigned myx = xb_xcc_id() & 7u;
    for (unsigned xo = 0; xo < 8u; ++xo) {
    const unsigned xq = (myx + xo) & 7u;
    for (;; ++it) {
        if (X.tid == 0) qslot[it & 1] = __hip_atomic_fetch_add(qctr + 64 + 64 * xq, 1u, RLX_AGENT);
        __syncthreads();
        const unsigned u = (unsigned)__builtin_amdgcn_readfirstlane((int)qslot[it & 1]);
        if (u >= 96u) { ++it; break; }
        const int qb = 31 - (int)(u / 3u), wh = (int)(u % 3u), sub = wh == 0 ? (int)xq : 8 + 2 * (int)xq + (wh - 1);
        if (sub < 8) {
            int tl = X.tid; asm volatile("" : "+v"(tl));
            { float kv[4][8];
#pragma unroll
              for (int q = 0; q < 4; ++q)
#pragma unroll
                  for (int rs = 0; rs < 8; ++rs) kv[q][rs] = km[(size_t)rs * 16384 + sub * 2048 + tl + 512 * q];
              asm volatile("" ::: "memory");
#pragma unroll
              for (int q = 0; q < 4; ++q) { float s = 0.f;
#pragma unroll
                  for (int rs = 0; rs < 8; ++rs) s += kv[q][rs];
                  kmL[tl + 512 * q] = s * (1.0f / 256.0f); } }
            __syncthreads();
            attn_body::attn_unit<8, 1>(qb, (const abf*)(proj + C_MQ + sub * 64), (const abf*)(proj + C_MK + sub * 64), (const abf*)(proj + C_MV + sub * 64), (abf*)(moba + sub * 64), 512,
                                       (char*)X.ldsg, posL, kmaxL, biasT + sub * 132, kmL);
        } else {
            const int v = sub - 8, h = v >> 2, m = (v >> 1) & 1, half = v & 1;
            attn_body::attn_unit<8, 0>(qb, (const abf*)(proj + C_DQ + h * 128 + m * 64), (const abf*)(proj + C_DK + h * 128 + m * 64), (const abf*)(proj + C_DV + h * 128 + half * 64),
                                       (abf*)(diff + (h * 2 + m) * 128 + half * 64), 1024, (char*)X.ldsg, posL, kmaxL, biasT + (8 + h) * 132, kmL);
        }
    }
    }
    DRAIN_CONV();
#undef DRAIN_CONV
}

__device__ __forceinline__ void bias_gemv8(const Ctx& X, const unsigned char* __restrict__ W8, const float* __restrict__ sh, float* __restrict__ bias, int nrows) {
    float s[32];
#pragma unroll
    for (int i = 0; i < 8; ++i) { const f32x4 v = *(const f32x4*)(sh + 32 * X.lane + 4 * i); s[4 * i] = v[0]; s[4 * i + 1] = v[1]; s[4 * i + 2] = v[2]; s[4 * i + 3] = v[3]; }
    typedef float f32x2 __attribute__((ext_vector_type(2)));
    for (int n0 = X.gw; n0 < nrows; n0 += 6 * X.ngw) {
        v4u ra[6], rb[6];
#pragma unroll
        for (int q = 0; q < 6; ++q) { const int n1 = n0 + q * X.ngw, n = n1 < nrows ? n1 : nrows - 1; ra[q] = *(const v4u*)(W8 + (size_t)n * DM + 32 * X.lane); rb[q] = *(const v4u*)(W8 + (size_t)n * DM + 32 * X.lane + 16); }
        asm volatile("" ::: "memory");
#pragma unroll
        for (int q = 0; q < 6; ++q) { const int n = n0 + q * X.ngw;
            const unsigned w[8] = {ra[q].x, ra[q].y, ra[q].z, ra[q].w, rb[q].x, rb[q].y, rb[q].z, rb[q].w}; float acc = 0.f;
#pragma unroll
            for (int i = 0; i < 8; ++i) { const f32x2 lo = __builtin_amdgcn_cvt_pk_f32_fp8((int)w[i], false), hi = __builtin_amdgcn_cvt_pk_f32_fp8((int)w[i], true);
                acc += s[4 * i] * lo[0] + s[4 * i + 1] * lo[1] + s[4 * i + 2] * hi[0] + s[4 * i + 3] * hi[1]; }
            acc = wave_sum(acc);
            if (n < nrows && X.lane == 0) bias[n] = acc * (1.0f / pg8::W8_SCALE); }
    }
}

struct P5In { const float* yraw; const bf16 *xc, *proj, *moba, *diff; const float *d_skip, *ssd_g, *moba_g, *lamp, *subln_g; float lambda_init; unsigned char* y; };
struct P5Row { f32x4 ya[2], yb[2]; v4u xr[2], zr[2], m4, a4, b4; };
__device__ __forceinline__ void p5_load(P5Row& R, const P5In& I, int t, int lane) {
#pragma unroll
    for (int g = 0; g < 2; ++g) { const int ch = g * 512 + 8 * lane;
        R.ya[g] = *(const f32x4*)(I.yraw + (size_t)t * 1024 + ch); R.yb[g] = *(const f32x4*)(I.yraw + (size_t)t * 1024 + ch + 4);
        R.xr[g] = *(const v4u*)(I.xc + (size_t)t * 1536 + ch); R.zr[g] = *(const v4u*)(I.proj + (size_t)t * NPROJ + C_Z + ch); }
    R.m4 = *(const v4u*)(I.moba + (size_t)t * 512 + 8 * lane);
    const int dh = lane >> 4, dd = 8 * (lane & 15);
    R.a4 = *(const v4u*)(I.diff + (size_t)t * 1024 + (dh * 2 + 0) * 128 + dd); R.b4 = *(const v4u*)(I.diff + (size_t)t * 1024 + (dh * 2 + 1) * 128 + dd);
}
__device__ __forceinline__ void p5_put8(const P5In& I, size_t off, const float (&v)[8], float r, const f32x4& g0, const f32x4& g1) {
#if OUTPROJ_FP8
    const float r8 = r * pg8::A8_SCALE; v2u o; o.x = pg8::pk4_fp8(v[0] * r8 * g0[0], v[1] * r8 * g0[1], v[2] * r8 * g0[2], v[3] * r8 * g0[3]); o.y = pg8::pk4_fp8(v[4] * r8 * g1[0], v[5] * r8 * g1[1], v[6] * r8 * g1[2], v[7] * r8 * g1[3]);
    *(v2u*)(I.y + off) = o;
#else
    v4u o; o.x = pk2(v[0] * r * g0[0], v[1] * r * g0[1]); o.y = pk2(v[2] * r * g0[2], v[3] * r * g0[3]); o.z = pk2(v[4] * r * g1[0], v[5] * r * g1[1]); o.w = pk2(v[6] * r * g1[2], v[7] * r * g1[3]);
    *(v4u*)((bf16*)I.y + off) = o;
#endif
}
struct P5Par { float D[2]; f32x4 gs[2][2], gm[2], gd[2]; float lam; };
__device__ __forceinline__ void p5_item(const P5Row& R, const P5In& I, const P5Par& P, int t, int lane) {
#pragma unroll
    for (int g = 0; g < 2; ++g) { const int ch = g * 512 + 8 * lane;
        const f32x4 y0 = R.ya[g], y1 = R.yb[g]; const v4u xv = R.xr[g], zv = R.zr[g];
        const float D = P.D[g];
        float v[8];
        v[0] = (y0[0] + D * bflo(xv.x)) * siluf(bflo(zv.x)); v[1] = (y0[1] + D * bfhi(xv.x)) * siluf(bfhi(zv.x));
        v[2] = (y0[2] + D * bflo(xv.y)) * siluf(bflo(zv.y)); v[3] = (y0[3] + D * bfhi(xv.y)) * siluf(bfhi(zv.y));
        v[4] = (y1[0] + D * bflo(xv.z)) * siluf(bflo(zv.z)); v[5] = (y1[1] + D * bfhi(xv.z)) * siluf(bfhi(zv.z));
        v[6] = (y1[2] + D * bflo(xv.w)) * siluf(bflo(zv.w)); v[7] = (y1[3] + D * bfhi(xv.w)) * siluf(bfhi(zv.w));
        float s = 0.f;
#pragma unroll
        for (int i = 0; i < 8; ++i) s += v[i] * v[i];
        s = wave_sum(s); const float r = 1.0f / sqrtf(s * (1.0f / 512.0f) + EPSF);
        p5_put8(I, (size_t)t * DM + ch, v, r, P.gs[g][0], P.gs[g][1]); }
    { const int ch = 8 * lane; const v4u r4 = R.m4;
      float v[8] = {bflo(r4.x), bfhi(r4.x), bflo(r4.y), bfhi(r4.y), bflo(r4.z), bfhi(r4.z), bflo(r4.w), bfhi(r4.w)}; float s = 0.f;
#pragma unroll
      for (int i = 0; i < 8; ++i) s += v[i] * v[i];
      s += __shfl_xor(s, 1); s += __shfl_xor(s, 2); s += __shfl_xor(s, 4);
      const float r = 1.0f / sqrtf(s * (1.0f / 64.0f) + EPSF);
      p5_put8(I, (size_t)t * DM + 1024 + ch, v, r, P.gm[0], P.gm[1]); }
    { const int h = lane >> 4, d = 8 * (lane & 15); const v4u a4 = R.a4, b4 = R.b4; const float lam = P.lam;
      float v[8] = {bflo(a4.x) - lam * bflo(b4.x), bfhi(a4.x) - lam * bfhi(b4.x), bflo(a4.y) - lam * bflo(b4.y), bfhi(a4.y) - lam * bfhi(b4.y),
                    bflo(a4.z) - lam * bflo(b4.z), bfhi(a4.z) - lam * bfhi(b4.z), bflo(a4.w) - lam * bflo(b4.w), bfhi(a4.w) - lam * bfhi(b4.w)}; float s = 0.f;
#pragma unroll
      for (int i = 0; i < 8; ++i) s += v[i] * v[i];
      s += __shfl_xor(s, 1); s += __shfl_xor(s, 2); s += __shfl_xor(s, 4); s += __shfl_xor(s, 8);
      const float r = (1.0f - I.lambda_init) / sqrtf(s * (1.0f / 128.0f) + EPSF);
      p5_put8(I, (size_t)t * DM + 1536 + h * 128 + d, v, r, P.gd[0], P.gd[1]); }
}
__device__ __forceinline__ void p5_finalize(const Ctx& X, const P5In& I) {
    P5Par P;
    { const float a = wave_sum(I.lamp[X.lane] * I.lamp[64 + X.lane]), b = wave_sum(I.lamp[128 + X.lane] * I.lamp[192 + X.lane]); P.lam = __expf(a) - __expf(b) + I.lambda_init; }
#pragma unroll
    for (int g = 0; g < 2; ++g) { const int ch = g * 512 + 8 * X.lane; P.D[g] = I.d_skip[ch >> 6]; P.gs[g][0] = *(const f32x4*)(I.ssd_g + ch); P.gs[g][1] = *(const f32x4*)(I.ssd_g + ch + 4); }
    P.gm[0] = *(const f32x4*)(I.moba_g + 8 * X.lane); P.gm[1] = *(const f32x4*)(I.moba_g + 8 * X.lane + 4);
    P.gd[0] = *(const f32x4*)(I.subln_g + 8 * (X.lane & 15)); P.gd[1] = *(const f32x4*)(I.subln_g + 8 * (X.lane & 15) + 4);
    P5Row A, B;
    p5_load(A, I, X.gw < NTOK ? X.gw : NTOK - 1, X.lane);
    for (int t = X.gw; t < NTOK; t += 2 * X.ngw) { const int t1 = t + X.ngw, t2 = t + 2 * X.ngw;
        p5_load(B, I, t1 < NTOK ? t1 : NTOK - 1, X.lane);
        p5_item(A, I, P, t, X.lane);
        p5_load(A, I, t2 < NTOK ? t2 : NTOK - 1, X.lane);
        if (t1 < NTOK) p5_item(B, I, P, t1, X.lane); }
}

__device__ __forceinline__ void moe_tab(const Ctx& X, const unsigned* cnt, LAS int* tab) {
    __syncthreads();
    if (X.tid < 64) {
        int n = X.tid < 8 ? (int)((__hip_atomic_load(cnt + (X.tid & 7), RLX_AGENT) + 255u) >> 8) : 0, inc = n;
#pragma unroll
        for (int o = 1; o < 8; o <<= 1) { const int v = __shfl_up(inc, o); if ((X.tid & 63) >= o) inc += v; }
        if (X.tid < 8) tab[X.tid] = inc - n;
        if (X.tid == 7) tab[8] = inc; }
    __syncthreads();
}
__device__ __forceinline__ void moe_gather(const Ctx& X, const unsigned char* __restrict__ H8, const unsigned* __restrict__ route, const LAS int* tab, unsigned char* __restrict__ XG8) {
    for (int t = X.gw; t < NTOK; t += X.ngw) {
        const unsigned* rt = route + (size_t)t * 8;
        const int r0 = tab[rt[0]] * 256 + (int)rt[2], r1 = tab[rt[1]] * 256 + (int)rt[3];
        const v4u* src = (const v4u*)(H8 + (size_t)t * DM) + X.lane;
        v4u* d0 = (v4u*)(XG8 + (size_t)r0 * DM) + X.lane; v4u* d1 = (v4u*)(XG8 + (size_t)r1 * DM) + X.lane;
#pragma unroll
        for (int j = 0; j < 2; ++j) { const v4u v = src[64 * j]; d0[64 * j] = v; d1[64 * j] = v; }
    }
}
__device__ __forceinline__ void moe_combine_final(const Ctx& X, const bf16* __restrict__ XA, const bf16* __restrict__ YG, const bf16* __restrict__ TAIL, int lfull, const unsigned* __restrict__ route, const LAS int* tab,
                                                  const float* __restrict__ gate, const float* __restrict__ fg, float* __restrict__ out) {
    LAS int* tailid = (LAS int*)(X.lds);
    for (int i = X.tid; i < 576; i += 512) tailid[i] = -1;
    __syncthreads();
    { const int nwg = tab[8] * 8, ntail = nwg > lfull ? nwg - lfull : 0;
      if (X.tid < ntail) { int pm, e, j; pg8::moe_unit_map(tab, 8, lfull + X.tid, pm, e, j); tailid[pm * 8 + j] = X.tid; } }
    __syncthreads();
    for (int t = X.gw; t < NTOK; t += X.ngw) {
        const unsigned* rt = route + (size_t)t * 8;
        const int r0 = tab[rt[0]] * 256 + (int)rt[2], r1 = tab[rt[1]] * 256 + (int)rt[3];
        const float w0 = __uint_as_float(rt[4]), w1 = __uint_as_float(rt[5]);
        v2u xr_[8], ar_[8], br_[8]; int ta[8], tb[8];
#pragma unroll
        for (int j = 0; j < 8; ++j) { ta[j] = tailid[(r0 >> 8) * 8 + j]; tb[j] = tailid[(r1 >> 8) * 8 + j]; }
#pragma unroll
        for (int j = 0; j < 8; ++j) { const int c = 4 * X.lane + 256 * j;
            xr_[j] = *(const v2u*)(XA + (size_t)t * DM + c);
            const bf16* pa = ta[j] < 0 ? YG + (size_t)r0 * DM + c : TAIL + (size_t)ta[j] * 65536 + (size_t)(r0 & 255) * 256 + 4 * X.lane;
            const bf16* pb = tb[j] < 0 ? YG + (size_t)r1 * DM + c : TAIL + (size_t)tb[j] * 65536 + (size_t)(r1 & 255) * 256 + 4 * X.lane;
            ar_[j] = *(const v2u*)pa; br_[j] = *(const v2u*)pb; }
        f32x4 v[8]; float s = 0.f;
#pragma unroll
        for (int j = 0; j < 8; ++j) { const int c = 4 * X.lane + 256 * j;
            const f32x4 x = {bflo(xr_[j].x), bfhi(xr_[j].x), bflo(xr_[j].y), bfhi(xr_[j].y)}, g = *(const f32x4*)(gate + c);
            f32x4 ya = {bflo(ar_[j].x), bfhi(ar_[j].x), bflo(ar_[j].y), bfhi(ar_[j].y)}, yb = {bflo(br_[j].x), bfhi(br_[j].x), bflo(br_[j].y), bfhi(br_[j].y)};
            if (ta[j] >= 0) { const bf16* p = TAIL + (size_t)ta[j] * 65536 + (size_t)(r0 & 255) * 256 + 4 * X.lane;
#pragma unroll
                for (int kp = 1; kp < 7; ++kp) { const v2u a = *(const v2u*)(p + (size_t)kp * 64 * 65536); ya += (f32x4){bflo(a.x), bfhi(a.x), bflo(a.y), bfhi(a.y)}; } }
            if (tb[j] >= 0) { const bf16* p = TAIL + (size_t)tb[j] * 65536 + (size_t)(r1 & 255) * 256 + 4 * X.lane;
#pragma unroll
                for (int kp = 1; kp < 7; ++kp) { const v2u b = *(const v2u*)(p + (size_t)kp * 64 * 65536); yb += (f32x4){bflo(b.x), bfhi(b.x), bflo(b.y), bfhi(b.y)}; } }
            v[j] = x + g * (ya * w0 + yb * w1); s += (v[j][0] * v[j][0] + v[j][1] * v[j][1]) + (v[j][2] * v[j][2] + v[j][3] * v[j][3]); }
        s = wave_sum(s); const float r = 1.0f / sqrtf(s * (1.0f / DM) + EPSF);
#pragma unroll
        for (int j = 0; j < 8; ++j) { const int c = 4 * X.lane + 256 * j; const f32x4 g = *(const f32x4*)(fg + c); *(f32x4*)(out + (size_t)t * DM + c) = v[j] * r * g; }
    }
}
struct Args { const void* in[27]; float* out; unsigned char* ws; int ph_lo, ph_hi, li, pad; };
using EpiUpD = pg8::EpiSwiGLU<44, FFD, true>; using EpiUpE = pg8::EpiSwiGLU<56, FFE>; using EpiDnE = pg8::EpiPlain<8, DM>;
#define GEMM_MULTI(EPI, SCH) pg8::gemm_phase<EPI, SCH, true, true>
#define GEMM_SINGLE(EPI, SCH) pg8::gemm_phase<EPI, SCH, false, true>
#define GEMM_MULTI8(EPI, SCH) pg8::gemm_phase<EPI, SCH, true, true, true>
#define GEMM_SINGLE8(EPI, SCH) pg8::gemm_phase<EPI, SCH, false, true, true>
#if MK_MULTI
#define GRID_BAR() do { } while (0)
#else
#define GRID_BAR() xcd_barrier(bar)
#endif
#define IN(k) (lo <= (k) && (k) < hi)
#define SEAM(k) do { if (IN(k) && IN((k) + 1)) GRID_BAR(); } while (0)
#ifndef PROBE_REP
#define PROBE_REP -1
#endif
#define REPS(P) for (int rep_ = 0; rep_ < ((P) == PROBE_REP ? 2 : 1); ++rep_)
#define REPBAR() do { if (rep_) GRID_BAR(); } while (0)
template <int l>
__device__ __forceinline__ void layer_body(unsigned char* lds_raw, const Args& args, const XcdBarrier& bar, const int lo, const int hi) {
    unsigned char* ws = args.ws;
    unsigned* ctl = (unsigned*)(ws + WS_CTL);
    LAS int* tab = (LAS int*)((LAS unsigned char*)lds_raw + LDSCTL_OFF + 256);
    volatile LAS unsigned* MISC = (volatile LAS unsigned*)((LAS unsigned char*)lds_raw + LDSCTL_OFF);
    const float* x_in = (const float*)args.in[0];
    const int* positions = (const int*)args.in[2];
    const float* rel_bias = (const float*)args.in[3];
    bf16* Hb = (bf16*)(ws + WS_H); bf16* PROJ = (bf16*)(ws + WS_PROJ); bf16* XC = (bf16*)(ws + WS_XC); bf16* Yb = (bf16*)(ws + WS_Y);
    bf16* MOBA = (bf16*)(ws + WS_MOBA); bf16* DIFF = (bf16*)(ws + WS_DIFF); bf16* Gb = (bf16*)(ws + WS_G); bf16* XG = (bf16*)(ws + WS_XG); bf16* YG = (bf16*)(ws + WS_YG);
    bf16* XA = (bf16*)(ws + WS_XA); float* YRAW = (float*)(ws + WS_YRAW); float* DT = (float*)(ws + WS_DT); float* DTV = (float*)(ws + WS_DTV); float* ACS = (float*)(ws + WS_ACS);
    float* KM = (float*)(ws + WS_KM); float* MOD = (float*)(ws + WS_MOD); const float* MODP = (const float*)(ws + WS_MODP);
    unsigned* ROUTE = (unsigned*)(ws + WS_ROUTE);

        constexpr int pb = l == 0 ? 1 : 12;
        const float* modl = MOD + (size_t)l * NMOD;
        const float lambda_init = l == 0 ? 0.2f : 0.8f - 0.6f * 0.7408182206817179f;
        if (IN(pb + 0)) REPS(pb + 0) { REPBAR(); const Ctx X = make_ctx(lds_raw);
            const float* b_ada = (const float*)args.in[5] + (size_t)l * NMOD; const float* g1 = (const float*)args.in[6] + (size_t)l * DM;
            for (int e = X.gtid; e < NMOD; e += X.ngt) { float m[5]; m[0] = b_ada[e];
#pragma unroll
                for (int ks = 0; ks < 4; ++ks) m[1 + ks] = MODP[(size_t)(ks * 2 + l) * NMOD + e];
                asm volatile("" ::: "memory");
                MOD[(size_t)l * NMOD + e] = (((m[0] + m[1]) + m[2]) + m[3]) + m[4]; }
            LAS float* sh = (LAS float*)(X.lds); LAS float* gs = (LAS float*)(X.lds + 8192);
            { float a0[4], a1[4], gg[4], m0[4][4], m1[4][4];
#pragma unroll
              for (int q = 0; q < 4; ++q) { const int c = X.tid + 512 * q; a0[q] = b_ada[c]; a1[q] = b_ada[DM + c]; gg[q] = g1[c];
#pragma unroll
                  for (int ks = 0; ks < 4; ++ks) { m0[q][ks] = MODP[(size_t)(ks * 2 + l) * NMOD + c]; m1[q][ks] = MODP[(size_t)(ks * 2 + l) * NMOD + DM + c]; } }
              asm volatile("" ::: "memory");
#pragma unroll
              for (int q = 0; q < 4; ++q) { const int c = X.tid + 512 * q; float s0 = a0[q], s1 = a1[q];
#pragma unroll
                  for (int ks = 0; ks < 4; ++ks) { s0 += m0[q][ks]; s1 += m1[q][ks]; }
                  sh[c] = s0; gs[c] = gg[q] * (1.0f + s1); } }
            __syncthreads();
            if (l == 0) rms_rows<false, true, false>(X, x_in, Hb, sh, gs, nullptr, nullptr, nullptr); else rms_rows<false, true, true>(X, XA, Hb, sh, gs, nullptr, nullptr, nullptr);
            __syncthreads();
        }
        SEAM(pb + 0);
        if (IN(pb + 1)) REPS(pb + 1) { REPBAR(); const Ctx X = make_ctx(lds_raw);
            pg8::Gemm g{Hb, (const bf16*)(ws + WS_WIN + (size_t)l * NPROJ_T * DM), NTOK, NPROJ_T, DM / 2}; pg8::StaticOrder S; S.init(NTOK, NPROJ_T, X.G, X.bx);
            pg8::EpiProj E{PROJ, DT, pg8::ACC8_INV};
            GEMM_MULTI8(pg8::EpiProj, pg8::StaticOrder)(X.lds + RING_OFF, g, S, E);
        }
        SEAM(pb + 1);
        if (IN(pb + 2)) REPS(pb + 2) { REPBAR(); const Ctx X = make_ctx(lds_raw);
            P3In I{PROJ, DT, (const float*)args.in[8] + (size_t)l * 4 * 1536, (const float*)args.in[9] + (size_t)l * 1536, (const float*)args.in[10] + l * 16, (const float*)args.in[11] + l * 16, XC, DTV, ACS, KM};
            p3_conv(X, I);
        }
        SEAM(pb + 2);
        if (IN(pb + 3)) { const Ctx X = make_ctx(lds_raw);
            for (int u = X.bx; u < 512; u += X.G) ssd_a_unit(X, XC, DTV, ACS, YRAW, (float*)(ws + WS_SST), u >> 4, u & 15);
            __syncthreads();
            const DefIn DI{(const float*)args.in[19], (const float*)args.in[20], (const float*)args.in[21], (const float*)args.in[23], (const float*)args.in[24], (const float*)args.in[25], ws};
            const P0In PI{(const float*)args.in[1], (const float*)args.in[4], (const float*)args.in[7], (const float*)args.in[17], nullptr, nullptr, nullptr, nullptr, nullptr, nullptr, ws};
            attn_phase(X, PROJ, KM, positions, rel_bias, MOBA, DIFF, ctl + CW_Q + 1024 * l, MISC + 16, DI, l * DEF_ITEMS_L, PI, l == 0 ? EXTRA_ITEMS : 0);
            __syncthreads();
        }
        SEAM(pb + 3);
        if (IN(pb + 4)) REPS(pb + 4) { const Ctx X = make_ctx(lds_raw); ssd_scan(X, (const float*)(ws + WS_SST), ACS, (bf16*)(ws + WS_HPREV));
            if (l == 0) bias_gemv8(X, ws + WS_W13, modl + 3 * DM, (float*)(ws + WS_BIASU), 2 * FFD); }
        SEAM(pb + 4);
        if (IN(pb + 5)) REPS(pb + 5) { REPBAR(); const Ctx X = make_ctx(lds_raw); for (int u = 16 + X.bx; u < 512; u += X.G) ssd_c_unit(X, XC, ACS, (const bf16*)(ws + WS_HPREV), YRAW, u >> 4, u & 15); }
        SEAM(pb + 5);
        if (IN(pb + 6)) REPS(pb + 6) { REPBAR(); const Ctx X = make_ctx(lds_raw);
            P5In I{YRAW, XC, PROJ, MOBA, DIFF, (const float*)args.in[12] + l * 16, (const float*)args.in[13] + (size_t)l * 1024, (const float*)args.in[14] + (size_t)l * 512,
                   (const float*)args.in[15] + (size_t)l * 256, (const float*)args.in[16] + (size_t)l * 128, lambda_init, (unsigned char*)Yb};
            p5_finalize(X, I);
        }
        SEAM(pb + 6);
        if (IN(pb + 7)) REPS(pb + 7) { REPBAR(); const Ctx X = make_ctx(lds_raw);
#if OUTPROJ_FP8
            pg8::Gemm g{Yb, (const bf16*)(ws + WS_WOUT + (size_t)l * DM * DM), NTOK, DM, DM / 2}; pg8::StaticOrder S; S.init(NTOK, DM, X.G, X.bx);
            if (l == 0) { typedef pg8::EpiResid<false, true> EpiO0; EpiO0 E{x_in, XA, modl + 2 * DM, pg8::ACC8_INV, (unsigned char*)Hb, (const float*)args.in[18], modl + 4 * DM, (float*)(ws + WS_ROWP), (LAS float*)(X.lds + 131072)};
                GEMM_MULTI8(EpiO0, pg8::StaticOrder)(X.lds + RING_OFF, g, S, E); }
            else { pg8::EpiResid<true> E{XA, XA, modl + 2 * DM, pg8::ACC8_INV, nullptr, nullptr, nullptr, nullptr, nullptr}; GEMM_SINGLE8(pg8::EpiResid<true>, pg8::StaticOrder)(X.lds + RING_OFF, g, S, E); }
#else
            pg8::Gemm g{Yb, (const bf16*)(ws + WS_WOUT) + (size_t)l * DM * DM, NTOK, DM, DM}; pg8::StaticOrder S; S.init(NTOK, DM, X.G, X.bx);
            if (l == 0) { typedef pg8::EpiResid<false, true> EpiO0; EpiO0 E{x_in, XA, modl + 2 * DM, 1.0f, (unsigned char*)Hb, (const float*)args.in[18], modl + 4 * DM, (float*)(ws + WS_ROWP), (LAS float*)(X.lds + 131072)};
                GEMM_MULTI(EpiO0, pg8::StaticOrder)(X.lds + RING_OFF, g, S, E); }
            else { pg8::EpiResid<true> E{XA, XA, modl + 2 * DM, 1.0f, nullptr, nullptr, nullptr, nullptr, nullptr}; GEMM_SINGLE(pg8::EpiResid<true>, pg8::StaticOrder)(X.lds + RING_OFF, g, S, E); }
#endif
        }
        SEAM(pb + 7);
        if (l == 1) {
        if (IN(pb + 8)) REPS(pb + 8) { REPBAR(); const Ctx X = make_ctx(lds_raw);
            const float* g2 = (const float*)args.in[18] + (size_t)l * DM;
            LAS float* sh = (LAS float*)(X.lds); LAS float* gs = (LAS float*)(X.lds + 8192);
            for (int c = X.tid; c < DM; c += 512) { sh[c] = modl[3 * DM + c]; gs[c] = g2[c] * (1.0f + modl[4 * DM + c]); }
            LAS float* rwL = (LAS float*)(X.lds + 16384);
            { const float* rw = (const float*)args.in[22]; for (int i = X.tid; i < DM * 8; i += 512) rwL[(i & 7) * DM + (i >> 3)] = rw[i]; }
            __syncthreads();
            rms_rows<true, true, true>(X, XA, ws + WS_XG8S, sh, gs, rwL, ctl + CW_CNT, ROUTE);
            __syncthreads();
        }
        SEAM(pb + 8);
        }
        if (l == 0) {
            if (IN(10)) REPS(10) { REPBAR(); const Ctx X = make_ctx(lds_raw);
                pg8::Gemm g{Hb, (const bf16*)(ws + WS_W13), NTOK, 2 * FFD, DM / 2}; pg8::StaticOrder S; S.init(NTOK, 2 * FFD, X.G, X.bx);
                EpiUpD E{(unsigned char*)Gb, (const float*)(ws + WS_ROWP), (const float*)(ws + WS_BIASU)};
                GEMM_MULTI8(EpiUpD, pg8::StaticOrder)(X.lds + RING_OFF, g, S, E);
            }
            SEAM(10);
            if (IN(11)) REPS(11) { REPBAR(); const Ctx X = make_ctx(lds_raw);
                pg8::Gemm g{Gb, (const bf16*)(ws + WS_W2), NTOK, DM, FFD / 2}; pg8::StaticOrder S; S.init(NTOK, DM, X.G, X.bx);
                pg8::EpiResid<true> E{XA, XA, modl + 5 * DM, pg8::ACC8_INV, nullptr, nullptr, nullptr, nullptr, nullptr};
                GEMM_SINGLE8(pg8::EpiResid<true>, pg8::StaticOrder)(X.lds + RING_OFF, g, S, E);
            }
            SEAM(11);
        } else {
            if (IN(22)) REPS(22) { REPBAR(); const Ctx X = make_ctx(lds_raw);
                moe_tab(X, ctl + CW_CNT, tab);
                pg8::Gemm g{(const bf16*)(ws + WS_XG8S), (const bf16*)(ws + WS_W13E), 8 * NTOK, 8 * 2 * FFE, DM / 2}; if (X.tid < 32) pg8::GroupedOrder::build(tab + 16, tab, 56, 1, 0, NTOK / 256, X.G, X.bx, X.tid); __syncthreads(); pg8::GroupedOrder S{tab + 16};
                EpiUpE E{(unsigned char*)Gb, nullptr, nullptr};
                GEMM_MULTI8(EpiUpE, pg8::GroupedOrder)(X.lds + RING_OFF, g, S, E);
            }
            SEAM(22);
            if (IN(23)) REPS(23) { REPBAR(); const Ctx X = make_ctx(lds_raw);
                moe_tab(X, ctl + CW_CNT, tab);
                { pg8::Gemm g{Gb, (const bf16*)(ws + WS_W2E), MAXROWS, 8 * DM, FFE / 2}; if (X.tid < 32) pg8::GroupedOrder::build_full(tab + 16, tab, 8, 2 * X.G, X.G, X.bx, X.tid); __syncthreads(); pg8::GroupedOrder S{tab + 16};
                  EpiDnE E{YG};
                  GEMM_MULTI8(EpiDnE, pg8::GroupedOrder)(X.lds + RING_OFF, g, S, E); }
                __syncthreads();
                { pg8::Gemm g{Gb, (const bf16*)(ws + WS_W2E), MAXROWS, 8 * DM, FFE / 2, FFE / 14}; if (X.tid < 32) pg8::GroupedOrder::build_tail(tab + 16, tab, 8, 2 * X.G, 7, FFE / 7, X.G, X.bx, X.tid); __syncthreads(); pg8::GroupedOrder S{tab + 16};
                  pg8::EpiTail E{(bf16*)(ws + WS_YG2)};
                  GEMM_MULTI8(pg8::EpiTail, pg8::GroupedOrder)(X.lds + RING_OFF, g, S, E); }
            }
            SEAM(23);
            if (IN(24)) REPS(24) { REPBAR(); const Ctx X = make_ctx(lds_raw); moe_tab(X, ctl + CW_CNT, tab); moe_combine_final(X, XA, YG, (const bf16*)(ws + WS_YG2), 2 * X.G, ROUTE, tab, modl + 5 * DM, (const float*)args.in[26], args.out); }
        }
    }
__global__ void __launch_bounds__(NWAVES * 64, 2) fwd(Args args) {
    extern __shared__ __attribute__((aligned(16))) unsigned char lds_raw[];
    unsigned char* ws = args.ws;
    unsigned* ctl = (unsigned*)(ws + WS_CTL);
    volatile LAS unsigned* MISC = (volatile LAS unsigned*)((LAS unsigned char*)lds_raw + LDSCTL_OFF);
    for (int u = threadIdx.x; u < (LDS_BYTES - LDSCTL_OFF) / 4; u += NWAVES * 64) ((LAS unsigned*)((LAS unsigned char*)lds_raw + LDSCTL_OFF))[u] = 0u;
    __syncthreads();
#if MK_MULTI
    XcdBarrier bar; bar.bar = ctl + CW_BAR; bar.x = 0; bar.st = MISC + 8;
#else
    XcdBarrier bar = xcd_barrier_post(ctl + CW_BAR, MISC + 8);
#endif
    const int lo = args.ph_lo, hi = args.ph_hi;

    if (IN(0)) REPS(0) { REPBAR(); const Ctx X = make_ctx(lds_raw);
        P0In I{(const float*)args.in[1], (const float*)args.in[4], (const float*)args.in[7], (const float*)args.in[17], (const float*)args.in[19], (const float*)args.in[20], (const float*)args.in[21],
               (const float*)args.in[23], (const float*)args.in[24], (const float*)args.in[25], ws};
        p0_prologue(X, I);
    }
    SEAM(0);

    layer_body<0>(lds_raw, args, bar, lo, hi);
    layer_body<1>(lds_raw, args, bar, lo, hi);
#undef IN
#undef SEAM
}

extern "C" void kernel_launch(void* const* d_in, const int* in_sizes, int n_in, void* d_out, int out_size, void* d_ws, size_t ws_size, hipStream_t stream) {
    static int grid = 0;
    if (grid == 0) {
        if (n_in != 27 || in_sizes[0] != NTOK * DM || out_size != NTOK * DM || ws_size < WS_END) {
            fprintf(stderr, "kernel_launch: expected 27 inputs, x/out of %d floats, >= %zu bytes of workspace; got n_in %d, in0 %d, out %d, ws %zu; nothing launched\n", NTOK * DM, (size_t)WS_END, n_in, n_in > 0 ? in_sizes[0] : -1, out_size, ws_size);
            grid = -1; return; }
        int dev = 0, cus = 0, per_cu = 0;
        if (hipGetDevice(&dev) != hipSuccess || hipDeviceGetAttribute(&cus, hipDeviceAttributeMultiprocessorCount, dev) != hipSuccess) { fprintf(stderr, "kernel_launch: device query failed\n"); grid = -1; return; }
        if (hipFuncSetAttribute((const void*)fwd, hipFuncAttributeMaxDynamicSharedMemorySize, LDS_BYTES) != hipSuccess) { fprintf(stderr, "kernel_launch: hipFuncSetAttribute failed\n"); grid = -1; return; }
        if (hipOccupancyMaxActiveBlocksPerMultiprocessor(&per_cu, (const void*)fwd, NWAVES * 64, LDS_BYTES) != hipSuccess || per_cu < 1)
            fprintf(stderr, "kernel_launch: note: occupancy query reports %d workgroups per CU\n", per_cu);
        (void)hipGetLastError();
        grid = cus;
    }
    if (grid < 0) return;
    if (hipMemsetAsync((char*)d_ws + WS_CTL, 0, CTL_ZERO_BYTES, stream) != hipSuccess) { fprintf(stderr, "kernel_launch: memset failed\n"); return; }
    Args a{};
    for (int i = 0; i < 27; ++i) a.in[i] = d_in[i];
    a.out = (float*)d_out; a.ws = (unsigned char*)d_ws; a.li = 0; a.pad = 0;
#if MK_MULTI
    for (int p = 0; p < NPHASE; ++p) { a.ph_lo = p; a.ph_hi = p + 1; hipLaunchKernelGGL(fwd, dim3(grid), dim3(NWAVES * 64), LDS_BYTES, stream, a); }
#else
    a.ph_lo = 0; a.ph_hi = NPHASE;
    hipLaunchKernelGGL(fwd, dim3(grid), dim3(NWAVES * 64), LDS_BYTES, stream, a);
#endif
    const hipError_t le = hipPeekAtLastError();
    if (le != hipSuccess) fprintf(stderr, "kernel_launch: launch failed: %s\n", hipGetErrorName(le));
}
```
